# Optimizing an MI355X kernel written in HIP

```python
import math
import jax, jax.numpy as jnp
from jax import lax
import numpy as np

D_MODEL = 1024
BATCH = 16
SEQ = 4096
DEPTH = 1
DEC_BATCH = 16
DEC_SEQ = 64
PAST_LEN = 4096

CHUNK = 64
Q_BLOCK = 128
N_META = 16
EPS = 1e-6
A_HEADS = 4
A_DH = 64
A_DV = 2 * A_DH
A_ROT = A_DH // 4
A_THETA = 500000.0
R_HEADS = 4
R_DK = 64
R_DV = 128
R_THETA = 10000.0
A_Q = A_HEADS * 2 * A_DH
A_K = A_HEADS * 2 * A_DH
A_V = A_HEADS * A_DV
R_Q = R_HEADS * R_DK
R_K = R_HEADS * R_DK
R_V = R_HEADS * R_DV
R_G = R_HEADS * R_DV
P_IN = A_Q + A_K + A_V + R_Q + R_K + R_V + R_G
SPLITS = (A_Q, A_Q + A_K, A_Q + A_K + A_V, A_Q + A_K + A_V + R_Q,
          A_Q + A_K + A_V + R_Q + R_K, A_Q + A_K + A_V + R_Q + R_K + R_V)
MIX = A_HEADS * A_DV + R_HEADS * R_DV
D_FF = ((-(-8 * D_MODEL // 3) + 255) // 256) * 256

kernel_name = "hymba_diffattn_retention_stream_step"


def rms_norm(x, g=None):
    xf = x.astype(jnp.float32)
    y = xf * lax.rsqrt(jnp.mean(xf * xf, axis=-1, keepdims=True) + EPS)
    if g is not None:
        y = y * g.astype(jnp.float32)
    return y.astype(x.dtype)


def rope(x, pos, rot_dim, theta):
    half = rot_dim // 2
    inv = theta ** (-jnp.arange(half, dtype=jnp.float32) / half)
    ang = pos.astype(jnp.float32)[:, None] * inv[None, :]
    ang = ang.reshape((pos.shape[0],) + (1,) * (x.ndim - 3) + (half,))
    cos, sin = jnp.cos(ang), jnp.sin(ang)
    xr = x[..., :rot_dim].astype(jnp.float32)
    x1, x2 = xr[..., :half], xr[..., half:]
    rot = jnp.concatenate([x1 * cos - x2 * sin, x2 * cos + x1 * sin], axis=-1).astype(x.dtype)
    return jnp.concatenate([rot, x[..., rot_dim:]], axis=-1)


def mix_inputs(x, pos, lw):
    B, T = x.shape[:2]
    z = rms_norm(x, lw['g_mix']) @ lw['w_in']
    aq, ak, av, rq, rk, rv, rg = jnp.split(z, SPLITS, axis=-1)
    q = rope(rms_norm(aq.reshape(B, T, A_HEADS, 2, A_DH), lw['g_q']), pos, A_ROT, A_THETA)
    k = rope(rms_norm(ak.reshape(B, T, A_HEADS, 2, A_DH), lw['g_k']), pos, A_ROT, A_THETA)
    q = q.reshape(B, T, A_HEADS, 2 * A_DH)
    k = k.reshape(B, T, A_HEADS, 2 * A_DH)
    v = av.reshape(B, T, A_HEADS, A_DV)
    rq = rope(rq.reshape(B, T, R_HEADS, R_DK), pos, R_DK, R_THETA)
    rk = rope(rk.reshape(B, T, R_HEADS, R_DK), pos, R_DK, R_THETA) * (R_DK ** -0.5)
    rv = rv.reshape(B, T, R_HEADS, R_DV)
    return (q, k, v), (rq, rk, rv, rg)


def diff_lambda(lw, lam_init):
    f = lambda a: a.astype(jnp.float32)
    return (jnp.exp(jnp.sum(f(lw['lam_q1']) * f(lw['lam_k1'])))
            - jnp.exp(jnp.sum(f(lw['lam_q2']) * f(lw['lam_k2']))) + lam_init)


def diff_attend(q, k, v, mask, lam):
    B, T = q.shape[:2]
    L = k.shape[1]
    qc = q.reshape(B, T, A_HEADS, 2, A_DH)
    kc = k.reshape(B, L, A_HEADS, 2, A_DH)
    s = jnp.einsum('bthcd,blhcd->bchtl', qc, kc, preferred_element_type=jnp.float32) * (A_DH ** -0.5)
    if mask is not None:
        s = jnp.where(mask, s, -1e30)
    p = jax.nn.softmax(s, axis=-1)
    a = p[:, 0] - lam * p[:, 1]
    return jnp.einsum('bhtl,blhv->bthv', a.astype(v.dtype), v)


def retention_log_decay():
    return jnp.log(1.0 - 2.0 ** (-5.0 - jnp.arange(R_HEADS, dtype=jnp.float32)))


def retention_state(k, v, S, log_g):
    C = k.shape[1]
    idx = jnp.arange(C, dtype=jnp.float32)
    w = jnp.exp((C - 1 - idx)[:, None] * log_g[None, :])
    return (jnp.exp(C * log_g)[None, :, None, None] * S
            + jnp.einsum('bchk,ch,bchv->bhkv', k, w, v))


def retention_block(q, k, v, S, log_g):
    C = q.shape[1]
    idx = jnp.arange(C, dtype=jnp.float32)
    diff = idx[:, None] - idx[None, :]
    D = jnp.where(diff[..., None] >= 0, jnp.exp(jnp.maximum(diff, 0.0)[..., None] * log_g), 0.0)
    s = jnp.einsum('bnhk,bmhk->bnmh', q, k) * D[None]
    o_in = jnp.einsum('bnmh,bmhv->bnhv', s, v)
    cross = jnp.exp((idx + 1.0)[:, None] * log_g[None, :])
    o_x = jnp.einsum('bnhk,nh,bhkv->bnhv', q, cross, S)
    return o_in + o_x, retention_state(k, v, S, log_g)


def mix_output(x, a_out, r_out, r_gate, lw, lam_init):
    B, T = x.shape[:2]
    a = (rms_norm(a_out, lw['g_sub']) * (1.0 - lam_init)).reshape(B, T, A_HEADS * A_DV)
    r = jax.nn.silu(r_gate) * rms_norm(r_out).reshape(B, T, R_HEADS * R_DV).astype(r_gate.dtype)
    h = x + jnp.concatenate([a.astype(x.dtype), r.astype(x.dtype)], axis=-1) @ lw['w_out']
    hn = rms_norm(h, lw['g_ffn'])
    return h + (jax.nn.silu(hn @ lw['w_gate']) * (hn @ lw['w_up'])) @ lw['w_down']


def prompt_layer(hm, h, lw, lam, lam_init, need_meta):
    B, S = h.shape[:2]
    pos_m = jnp.arange(N_META, dtype=jnp.int32)
    pos_f = N_META + jnp.arange(S, dtype=jnp.int32)
    (aqm, akm, avm), (rqm, rkm, rvm, rgm) = mix_inputs(hm, pos_m, lw)
    (aq, ak, av), (rq, rk, rv, rg) = mix_inputs(h, pos_f, lw)
    k_all = jnp.concatenate([jnp.broadcast_to(akm, (B,) + akm.shape[1:]), ak], axis=1)
    v_all = jnp.concatenate([jnp.broadcast_to(avm, (B,) + avm.shape[1:]), av], axis=1)
    key_chunk = jnp.concatenate([jnp.full((N_META,), -1, jnp.int32), jnp.arange(S, dtype=jnp.int32) // CHUNK])
    nb = S // Q_BLOCK
    q_blocks = jnp.moveaxis(aq.reshape(B, nb, Q_BLOCK, A_HEADS, 2 * A_DH), 1, 0)

    def attend_block(args):
        qb, b = args
        q_chunk = (b * Q_BLOCK + jnp.arange(Q_BLOCK, dtype=jnp.int32)) // CHUNK
        mask = key_chunk[None, :] <= q_chunk[:, None]
        return diff_attend(qb, k_all, v_all, mask, lam)

    ao = lax.map(attend_block, (q_blocks, jnp.arange(nb, dtype=jnp.int32)))
    ao = jnp.moveaxis(ao, 0, 1).reshape(B, S, A_HEADS, A_DV)
    log_g = retention_log_decay()
    s0 = jnp.zeros((1, R_HEADS, R_DK, R_DV), jnp.float32)
    if need_meta:
        rom, s_meta = retention_block(rqm, rkm, rvm, s0, log_g)
    else:
        s_meta = retention_state(rkm, rvm, s0, log_g)
    nc = S // CHUNK

    def to_chunks(t):
        return jnp.moveaxis(t.reshape((B, nc, CHUNK) + t.shape[2:]), 1, 0)

    def step(state, qkv):
        o, state = retention_block(*qkv, state, log_g)
        return state, o

    s_fin, ro = lax.scan(step, jnp.broadcast_to(s_meta, (B,) + s_meta.shape[1:]),
                         (to_chunks(rq), to_chunks(rk), to_chunks(rv)))
    ro = jnp.moveaxis(ro, 0, 1).reshape(B, S, R_HEADS, R_DV)
    h = mix_output(h, ao, ro, rg, lw, lam_init)
    if need_meta:
        aom = diff_attend(aqm, akm, avm, None, lam)
        hm = mix_output(hm, aom, rom, rgm, lw, lam_init)
    return hm, h, k_all, v_all, s_fin


def sample_layer(h, ck, cv, S, lw, lam, lam_init):
    B, T = h.shape[:2]
    pos = N_META + PAST_LEN + jnp.arange(T, dtype=jnp.int32)
    (aq, ak, av), (rq, rk, rv, rg) = mix_inputs(h, pos, lw)
    k_all = jnp.concatenate([ck, ak.astype(ck.dtype)], axis=1)
    v_all = jnp.concatenate([cv, av.astype(cv.dtype)], axis=1)
    ao = diff_attend(aq, k_all, v_all, None, lam)
    ro, s_new = retention_block(rq, rk, rv, S, retention_log_decay())
    h = mix_output(h, ao, ro, rg, lw, lam_init)
    return h, ak, av, s_new


def setup_inputs(seed: int = 0) -> dict:
    key = jax.random.key(seed)
    ks = jax.random.split(key, 24)
    nrm = lambda k, shape, s: jax.random.normal(k, shape, jnp.float32) * s
    return {
        'x_prompt': nrm(ks[0], (BATCH, SEQ, D_MODEL), 1.0),
        'x_sample': nrm(ks[1], (DEC_BATCH, DEC_SEQ, D_MODEL), 1.0),
        'cache_k': nrm(ks[2], (DEPTH, DEC_BATCH, N_META + PAST_LEN, A_HEADS, 2 * A_DH), 1.0),
        'cache_v': nrm(ks[3], (DEPTH, DEC_BATCH, N_META + PAST_LEN, A_HEADS, A_DV), 1.0),
        'state_ret': nrm(ks[4], (DEPTH, DEC_BATCH, R_HEADS, R_DK, R_DV), 0.5),
        'meta': nrm(ks[5], (N_META, D_MODEL), 1.0),
        'g_mix': 1.0 + nrm(ks[6], (DEPTH, D_MODEL), 0.1),
        'w_in': nrm(ks[7], (DEPTH, D_MODEL, P_IN), D_MODEL ** -0.5),
        'g_q': 1.0 + nrm(ks[8], (DEPTH, A_DH), 0.1),
        'g_k': 1.0 + nrm(ks[9], (DEPTH, A_DH), 0.1),
        'lam_q1': nrm(ks[10], (DEPTH, A_DH), 0.1),
        'lam_k1': nrm(ks[11], (DEPTH, A_DH), 0.1),
        'lam_q2': nrm(ks[12], (DEPTH, A_DH), 0.1),
        'lam_k2': nrm(ks[13], (DEPTH, A_DH), 0.1),
        'g_sub': 1.0 + nrm(ks[14], (DEPTH, A_DV), 0.1),
        'w_out': nrm(ks[15], (DEPTH, MIX, D_MODEL), MIX ** -0.5),
        'g_ffn': 1.0 + nrm(ks[16], (DEPTH, D_MODEL), 0.1),
        'w_gate': nrm(ks[17], (DEPTH, D_MODEL, D_FF), D_MODEL ** -0.5),
        'w_up': nrm(ks[18], (DEPTH, D_MODEL, D_FF), D_MODEL ** -0.5),
        'w_down': nrm(ks[19], (DEPTH, D_FF, D_MODEL), D_FF ** -0.5),
    }


def reference(x_prompt, x_sample, cache_k, cache_v, state_ret, meta, g_mix, w_in, g_q, g_k,
              lam_q1, lam_k1, lam_q2, lam_k2, g_sub, w_out, g_ffn, w_gate, w_up, w_down):
    hm = meta[None].astype(x_prompt.dtype)
    hp = x_prompt
    hs = x_sample
    kp, vp, sp, ksn, vsn, ssn = [], [], [], [], [], []
    for l in range(DEPTH):
        lw = dict(g_mix=g_mix[l], w_in=w_in[l], g_q=g_q[l], g_k=g_k[l],
                  lam_q1=lam_q1[l], lam_k1=lam_k1[l], lam_q2=lam_q2[l], lam_k2=lam_k2[l],
                  g_sub=g_sub[l], w_out=w_out[l], g_ffn=g_ffn[l],
                  w_gate=w_gate[l], w_up=w_up[l], w_down=w_down[l])
        lam_init = 0.8 - 0.6 * math.exp(-0.3 * l)
        lam = diff_lambda(lw, lam_init)
        hm, hp, k_l, v_l, s_l = prompt_layer(hm, hp, lw, lam, lam_init, l < DEPTH - 1)
        hs, ks_l, vs_l, ss_l = sample_layer(hs, cache_k[l], cache_v[l], state_ret[l], lw, lam, lam_init)
        kp.append(k_l); vp.append(v_l); sp.append(s_l)
        ksn.append(ks_l); vsn.append(vs_l); ssn.append(ss_l)
    return (hp, hs, jnp.stack(kp), jnp.stack(vp), jnp.stack(sp), jnp.stack(ksn), jnp.stack(vsn), jnp.stack(ssn))
```

```cpp
#include <hip/hip_runtime.h>
#include <hip/hip_cooperative_groups.h>
#include <cstdio>
#include <cstdint>
namespace cg = cooperative_groups;
#ifndef PHMASK
#define PHMASK 63
#endif
#ifndef MK_LAUNCHES
#define MK_LAUNCHES 1
#endif
__device__ __forceinline__ int launder_tid() { int x = threadIdx.x; asm volatile("" : "+v"(x)); return x; }
namespace pg8 {
#define PG8_LAS __attribute__((address_space(3)))
typedef unsigned short bf16_t;
typedef short bf16x8 __attribute__((ext_vector_type(8)));
typedef float f32x4 __attribute__((ext_vector_type(4)));
typedef unsigned u32x4 __attribute__((ext_vector_type(4)));
constexpr int BM = 256, BK = 64, HALF = 128, HTB = HALF * BK * 2  , STAGE_BYTES = 8 * HTB, NXCD = 8, WGM = 8;

__host__ __device__ __forceinline__ int lds_byte(int r, int c) { const int st = (r >> 4) * 2 + (c >> 5), rr = r & 15, cc = c & 31, ob = rr * 64 + cc * 2; return st * 1024 + (ob ^ (((ob >> 9) & 1) << 5)); }
__host__ __device__ __forceinline__ void stage_rc(int b, int& R, int& C) { const int st = b / 1024, sb = b % 1024, swz = sb ^ (((sb >> 9) & 1) << 5); R = (st >> 1) * 16 + swz / 64; C = (st & 1) * 32 + (swz % 64) / 2; }
__host__ __device__ __forceinline__ int perm32(int rho) { const int n = rho >> 4, i = rho & 15; return 8 * (i >> 2) + 4 * n + (i & 3); }

struct Unit { int pm, pn; };
struct Gemm { const bf16_t* A; const bf16_t* Bt; int M, N, K; };

struct StaticOrder {
    int nM, nN, nwg, G, c;
    __host__ __device__ void init(int M, int N, int G_, int c_) { nM = M / BM; nN = N / BM; nwg = nM * nN; G = G_; c = c_; }
    __host__ __device__ bool next(int i, Unit& u) const {
        const long L = (long)i * G + c; if (L >= nwg) return false;
        int wgid = (int)L; { const int q = nwg / NXCD, r = nwg % NXCD, xcd = wgid % NXCD, off = wgid / NXCD; wgid = (xcd < r ? xcd * (q + 1) : r * (q + 1) + (xcd - r) * q) + off; }
        const int nig = WGM * nN, gid = wgid / nig, fm = gid * WGM, gsz = (nM - fm) < WGM ? (nM - fm) : WGM;
        u.pm = fm + ((wgid % nig) % gsz); u.pn = (wgid % nig) / gsz; return true;
    }
    __device__ __forceinline__ void a_ready(const Unit&) const {}
    __device__ __forceinline__ void done(const Unit&) const {}
};
template <class Epi, class Sched, bool ALIGN_EPI = false, bool SP2 = false>
__device__ __forceinline__ void gemm_phase(PG8_LAS unsigned char* lds, const Gemm g, const Sched& S, const Epi& E) {
    const int tid = launder_tid(), wid = __builtin_amdgcn_readfirstlane(tid >> 6), lane = tid & 63, wr = wid >> 2, wc = wid & 3, fr = lane & 15, fq = lane >> 4;
    const int K = g.K, nt = K / BK;
    unsigned voffA[2], voffB[2];
#pragma unroll
    for (int i = 0; i < 2; ++i) { int R, C; stage_rc(tid * 16 + i * 8192, R, C); const int Rb = Epi::PERM ? ((R & ~31) + perm32(R & 31)) : R;
        voffA[i] = (unsigned)(R * K + C) * 2u; voffB[i] = (unsigned)(Rb * K + C) * 2u; }
    const size_t kstep = (size_t)(BK * 2);
    const size_t hstep = (size_t)HALF * K * 2;
    const size_t tstep = 2 * hstep;
    const unsigned ldsw = (unsigned)wid * 1024u;
    const int aoff = lds_byte(wr * 64 + fr, fq * 8), boff = lds_byte(wc * 32 + fr, fq * 8);
#define PG8_SA(b, h) (((b) * 2 + (h)) * HTB)
#define PG8_SB(b, h) ((4 + (b) * 2 + (h)) * HTB)
#define PG8_STAGE(bufoff, gbase, voff) do { _Pragma("unroll") for (int _i = 0; _i < 2; ++_i) \
        __builtin_amdgcn_global_load_lds((const unsigned*)((const char*)(gbase) + (voff)[_i]), (PG8_LAS unsigned*)(lds + (bufoff) + ldsw + _i * 8192), 16, 0, 0); } while (0)
#define PG8_LDA(dst, b, h) do { _Pragma("unroll") for (int m = 0; m < 4; ++m) _Pragma("unroll") for (int k = 0; k < 2; ++k) dst[m][k] = *(const PG8_LAS bf16x8*)(lds + PG8_SA(b, h) + aoff + m * 2048 + k * 1024); } while (0)
#define PG8_LDB(dst, b, h) do { _Pragma("unroll") for (int n = 0; n < 2; ++n) _Pragma("unroll") for (int k = 0; k < 2; ++k) dst[n][k] = *(const PG8_LAS bf16x8*)(lds + PG8_SB(b, h) + boff + n * 2048 + k * 1024); } while (0)
#define PG8_MMA(ai, bj, At, Bt) do { __builtin_amdgcn_s_setprio(1); _Pragma("unroll") for (int m = 0; m < 4; ++m) _Pragma("unroll") for (int n = 0; n < 2; ++n) _Pragma("unroll") for (int k = 0; k < 2; ++k) \
        acc[ai][bj][m][n] = __builtin_amdgcn_mfma_f32_16x16x32_bf16(Bt[n][k], At[m][k], acc[ai][bj][m][n], 0, 0, 0); __builtin_amdgcn_s_setprio(0); } while (0)
#define PG8_WAIT_V(n) asm volatile("s_waitcnt vmcnt(" #n ")" ::: "memory")
#define PG8_WAIT_L(n) asm volatile("s_waitcnt lgkmcnt(" #n ")" ::: "memory")
#define PG8_BAR __builtin_amdgcn_s_barrier()
#define PG8_SCHED __builtin_amdgcn_sched_barrier(0)
    Unit cur, nxt; int ui = 0;
    if (!S.next(0, cur)) return;
    f32x4 acc[2][2][4][2];
#pragma unroll
    for (int a = 0; a < 2; ++a)
#pragma unroll
        for (int b = 0; b < 2; ++b)
#pragma unroll
            for (int m = 0; m < 4; ++m)
#pragma unroll
                for (int n = 0; n < 2; ++n) acc[a][b][m][n] = (f32x4){0.f, 0.f, 0.f, 0.f};
    bf16x8 At[4][2], B0[2][2], B1[2][2];
    const char* cA = (const char*)g.A + (size_t)cur.pm * tstep; const char* cB = (const char*)g.Bt + (size_t)cur.pn * tstep;
    S.a_ready(cur);
    if constexpr (SP2) {
        PG8_STAGE(PG8_SB(0, 0), cB, voffB); PG8_STAGE(PG8_SB(0, 1), cB + hstep, voffB); PG8_STAGE(PG8_SA(0, 0), cA, voffA); PG8_STAGE(PG8_SA(0, 1), cA + hstep, voffA);
        if (wr == 1) PG8_BAR;
        PG8_WAIT_V(2); PG8_BAR;
        PG8_STAGE(PG8_SB(1, 0), cB + kstep, voffB); PG8_STAGE(PG8_SA(1, 0), cA + kstep, voffA); PG8_STAGE(PG8_SB(1, 1), cB + hstep + kstep, voffB);
        PG8_WAIT_V(6); PG8_BAR;
    } else {
        PG8_STAGE(PG8_SB(0, 0), cB, voffB); PG8_STAGE(PG8_SA(0, 0), cA, voffA); PG8_STAGE(PG8_SB(0, 1), cB + hstep, voffB); PG8_STAGE(PG8_SA(0, 1), cA + hstep, voffA);
        if (wr == 1) PG8_BAR;
        PG8_WAIT_V(4); PG8_BAR;
        PG8_STAGE(PG8_SB(1, 0), cB + kstep, voffB); PG8_STAGE(PG8_SA(1, 0), cA + kstep, voffA); PG8_STAGE(PG8_SB(1, 1), cB + hstep + kstep, voffB);
        PG8_WAIT_V(6); PG8_BAR;
    }
    for (;;) {
        const bool has_next = S.next(ui + 1, nxt);
        const char* nA = has_next ? (const char*)g.A + (size_t)nxt.pm * tstep : cA; const char* nB = has_next ? (const char*)g.Bt + (size_t)nxt.pn * tstep : cB;
        for (int t = 0; t < nt; t += 2) {
            const bool last = (t == nt - 2);
            const char* a1 = cA + (size_t)(t + 1) * kstep;
            const char* a2 = last ? nA : cA + (size_t)(t + 2) * kstep; const char* b2 = last ? nB : cB + (size_t)(t + 2) * kstep;
            const char* a3 = a2 + kstep; const char* b3 = b2 + kstep;
            if (last && has_next) S.a_ready(nxt);
            if constexpr (SP2) {
            PG8_LDB(B0, 0, 0); PG8_LDB(B1, 0, 1); PG8_SCHED; PG8_LDA(At, 0, 0); PG8_STAGE(PG8_SA(1, 1), a1 + hstep, voffA);
            PG8_WAIT_V(8); PG8_WAIT_L(0); PG8_BAR; PG8_MMA(0, 0, At, B0); PG8_MMA(0, 1, At, B1); PG8_BAR; PG8_SCHED;
            PG8_LDA(At, 0, 1); PG8_STAGE(PG8_SB(0, 0), b2, voffB); PG8_STAGE(PG8_SB(0, 1), b2 + hstep, voffB); PG8_STAGE(PG8_SA(0, 0), a2, voffA);
            PG8_WAIT_V(8); PG8_WAIT_L(0); PG8_BAR; PG8_MMA(1, 0, At, B0); PG8_MMA(1, 1, At, B1); PG8_BAR; PG8_SCHED;
            PG8_LDB(B0, 1, 0); PG8_LDB(B1, 1, 1); PG8_SCHED; PG8_LDA(At, 1, 0); PG8_STAGE(PG8_SA(0, 1), a2 + hstep, voffA);
            PG8_WAIT_V(8); PG8_WAIT_L(0); PG8_BAR; PG8_MMA(0, 0, At, B0); PG8_MMA(0, 1, At, B1); PG8_BAR; PG8_SCHED;
            PG8_LDA(At, 1, 1); PG8_STAGE(PG8_SB(1, 0), b3, voffB); PG8_STAGE(PG8_SB(1, 1), b3 + hstep, voffB); PG8_STAGE(PG8_SA(1, 0), a3, voffA);
            PG8_WAIT_V(8); PG8_WAIT_L(0); PG8_BAR; PG8_MMA(1, 0, At, B0); PG8_MMA(1, 1, At, B1); PG8_BAR; PG8_SCHED;
            } else {
            PG8_LDB(B0, 0, 0); PG8_SCHED; PG8_LDA(At, 0, 0); PG8_STAGE(PG8_SA(1, 1), a1 + hstep, voffA);
            PG8_WAIT_L(8); PG8_BAR; PG8_WAIT_L(0); PG8_MMA(0, 0, At, B0); PG8_BAR; PG8_SCHED;
            PG8_LDB(B1, 0, 1); PG8_STAGE(PG8_SB(0, 0), b2, voffB);
            PG8_BAR; PG8_WAIT_L(0); PG8_MMA(0, 1, At, B1); PG8_BAR;
            PG8_LDA(At, 0, 1); PG8_STAGE(PG8_SA(0, 0), a2, voffA);
            PG8_BAR; PG8_WAIT_L(0); PG8_MMA(1, 0, At, B0); PG8_BAR; PG8_SCHED;
            PG8_STAGE(PG8_SB(0, 1), b2 + hstep, voffB);
            PG8_WAIT_V(6); PG8_BAR; PG8_MMA(1, 1, At, B1); PG8_BAR;
            PG8_LDB(B0, 1, 0); PG8_SCHED; PG8_LDA(At, 1, 0); PG8_STAGE(PG8_SA(0, 1), a2 + hstep, voffA);
            PG8_WAIT_L(8); PG8_BAR; PG8_WAIT_L(0); PG8_MMA(0, 0, At, B0); PG8_BAR; PG8_SCHED;
            PG8_LDB(B1, 1, 1); PG8_STAGE(PG8_SB(1, 0), b3, voffB);
            PG8_BAR; PG8_WAIT_L(0); PG8_MMA(0, 1, At, B1); PG8_BAR;
            PG8_LDA(At, 1, 1); PG8_STAGE(PG8_SA(1, 0), a3, voffA);
            PG8_BAR; PG8_WAIT_L(0); PG8_MMA(1, 0, At, B0); PG8_BAR; PG8_SCHED;
            PG8_STAGE(PG8_SB(1, 1), b3 + hstep, voffB);
            PG8_WAIT_V(6); PG8_BAR; PG8_MMA(1, 1, At, B1); PG8_BAR;
            }
        }
        if constexpr (ALIGN_EPI) { if (wr == 0) PG8_BAR; }
        if constexpr (!Epi::AFTER_DRAIN) { E(acc, cur, wr, wc, fr, fq); S.done(cur); }
        if (!has_next) break;
#pragma unroll
        for (int a = 0; a < 2; ++a)
#pragma unroll
            for (int b = 0; b < 2; ++b)
#pragma unroll
                for (int m = 0; m < 4; ++m)
#pragma unroll
                    for (int n = 0; n < 2; ++n) acc[a][b][m][n] = (f32x4){0.f, 0.f, 0.f, 0.f};
        cur = nxt; cA = nA; cB = nB; ++ui;
        if constexpr (ALIGN_EPI) { if (wr == 1) PG8_BAR; }
    }
    PG8_WAIT_V(0);
    if constexpr (!ALIGN_EPI) { if (wr == 0) PG8_BAR; }
    PG8_BAR;
    if constexpr (Epi::AFTER_DRAIN) { E.fused(acc, cur, wr, wc, fr, fq, lds, wid, lane); S.done(cur); }
#undef PG8_SA
#undef PG8_SB
#undef PG8_STAGE
#undef PG8_LDA
#undef PG8_LDB
#undef PG8_MMA
#undef PG8_WAIT_V
#undef PG8_WAIT_L
#undef PG8_BAR
#undef PG8_SCHED
}
}

typedef unsigned short bf16_t;
typedef short bf16x8 __attribute__((ext_vector_type(8)));
typedef short s16x4 __attribute__((ext_vector_type(4)));
typedef short v4i16_t __attribute__((ext_vector_type(4)));
typedef float f32x4 __attribute__((ext_vector_type(4)));
typedef float f32x16 __attribute__((ext_vector_type(16)));
typedef unsigned u32x4 __attribute__((ext_vector_type(4)));
typedef unsigned u32x2 __attribute__((ext_vector_type(2)));
typedef float f32x2_t __attribute__((ext_vector_type(2)));
typedef __bf16 bf16x2_t __attribute__((ext_vector_type(2)));
#define LAS __attribute__((address_space(3)))
#define DI __device__ __forceinline__
using pg8::Unit; using pg8::Gemm; using pg8::StaticOrder;

constexpr int DM = 1024, SEQ = 4096, NB = 16, NMETA = 16, LCACHE = 4112, DSEQ = 64;
constexpr int ROW_S = 65536, ROW_M = 66560, M1 = 66816, M2 = 66560;
constexpr int PIN = 3072, DFF = 2816, NGU = 5632;
constexpr float EPS = 1e-6f;
constexpr int NPOS = 4176;
constexpr int LDS_BYTES = 163840;
constexpr int LDS_POFF = LDS_BYTES - 64 - 512 * 32;
constexpr size_t O_YP = 0, O_YS = 67108864, O_KP = 68157440, O_VP = 101842944, O_SP = 135528448, O_KS = 136052736, O_VS = 136577024, O_SS = 137101312;
constexpr size_t al256(size_t x) { return (x + 255) & ~(size_t)255; }
constexpr size_t WS_CTL = 0;
constexpr size_t WS_TABA = 8192;
constexpr size_t WS_TABR = al256(WS_TABA + (size_t)NPOS * 16 * 4);
constexpr size_t WS_WIN = al256(WS_TABR + (size_t)NPOS * 64 * 4);
constexpr size_t WS_WOUT = WS_WIN + (size_t)PIN * DM * 2;
constexpr size_t WS_WGU = WS_WOUT + (size_t)DM * DM * 2;
constexpr size_t WS_WDN = WS_WGU + (size_t)NGU * DM * 2;
constexpr size_t WS_XN = WS_WDN + (size_t)DM * DFF * 2;
constexpr size_t WS_SSQ = WS_XN + (size_t)M1 * DM * 2;
constexpr size_t WS_QB = al256(WS_SSQ + (size_t)M2 * 16 * 4);
constexpr size_t WS_KB = WS_QB + (size_t)M1 * 512 * 2;
constexpr size_t WS_VB = WS_KB + (size_t)M1 * 512 * 2;
constexpr size_t WS_RQB = WS_VB + (size_t)M1 * 512 * 2;
constexpr size_t WS_RKB = WS_RQB + (size_t)M1 * 256 * 2;
constexpr size_t WS_RVB = WS_RKB + (size_t)M1 * 256 * 2;
constexpr size_t WS_RGB = WS_RVB + (size_t)M1 * 512 * 2;
constexpr size_t WS_ACT = WS_QB;
constexpr size_t WS_CKB = WS_RGB + (size_t)M1 * 512 * 2;
constexpr size_t WS_CVB = WS_CKB + (size_t)NB * LCACHE * 512 * 2;
constexpr size_t WS_MIX = WS_CVB + (size_t)NB * LCACHE * 512 * 2;
constexpr size_t WS_TLK = WS_MIX + (size_t)M2 * DM * 2;
constexpr size_t WS_TLV = WS_TLK + (size_t)NB * 64 * 512 * 2;
constexpr size_t WS_T = WS_TLV + (size_t)NB * 64 * 512 * 2;
constexpr size_t WS_RINV = WS_T + (size_t)NB * 4 * 8 * 8192 * 4;
constexpr size_t WS_END = WS_RINV + (size_t)M2 * 4;
static_assert(WS_ACT + (size_t)M2 * DFF * 2 <= WS_CKB, "ACT overlay fits");

struct Params {
    const float *x_prompt, *x_sample, *cache_k, *cache_v, *state_ret, *meta, *g_mix, *w_in, *g_q, *g_k, *lam_q1, *lam_k1, *lam_q2, *lam_k2, *g_sub, *w_out, *g_ffn, *w_gate, *w_up, *w_down;
    float* out; unsigned char* ws;
    int ph_lo, ph_hi;
};

DI unsigned cvtpk(float lo, float hi) { f32x2_t v = {lo, hi}; bf16x2_t b = __builtin_convertvector(v, bf16x2_t); return __builtin_bit_cast(unsigned, b); }
DI float bf2f(unsigned short u) { return __uint_as_float(((unsigned)u) << 16); }
DI float bflo(unsigned u) { return __uint_as_float(u << 16); }
DI float bfhi(unsigned u) { return __uint_as_float(u & 0xffff0000u); }
DI int crow(int r, int hi) { return (r & 3) + 8 * (r >> 2) + 4 * hi; }
DI float shx(float v, int m) { return __shfl_xor(v, m, 64); }
DI bf16x8 pack8(const f32x16& x, int s) {
    u32x4 p; p.x = cvtpk(x[8 * s], x[8 * s + 1]); p.y = cvtpk(x[8 * s + 2], x[8 * s + 3]); p.z = cvtpk(x[8 * s + 4], x[8 * s + 5]); p.w = cvtpk(x[8 * s + 6], x[8 * s + 7]);
    return __builtin_bit_cast(bf16x8, p);
}
DI s16x4 vtr(const LAS char* p) { return __builtin_bit_cast(s16x4, __builtin_amdgcn_ds_read_tr16_b64_v4i16((LAS v4i16_t*)p)); }
DI bf16x8 cat4(s16x4 lo, s16x4 hi) { return __builtin_shufflevector(lo, hi, 0, 1, 2, 3, 4, 5, 6, 7); }
#define MFMA32(a, b, c) __builtin_amdgcn_mfma_f32_32x32x16_bf16((a), (b), (c), 0, 0, 0)
DI float silu_f(float x) { return x * __builtin_amdgcn_rcpf(1.0f + __expf(-x)); }
DI float wave_sum(float v) { v += shx(v, 32); v += shx(v, 16); v += shx(v, 8); v += shx(v, 4); v += shx(v, 2); v += shx(v, 1); return v; }

DI int win_src(int n) { const int pn = n >> 8, c = n & 255; if (pn <= 3 || pn == 6 || pn == 7) { const int bj = c >> 7, j = (c >> 5) & 3, e = bj * 32 + (c & 31); return pn * 256 + j * 64 + e; } return n; }

DI void p0_transpose_tile(const float* W0, const float* W1, int ldw, int K, const float* gk, bf16_t* Bt, int mode, int k0, int n0, LAS float* scr) {
    const int tid = launder_tid();
#pragma unroll
    for (int i = 0; i < 8; ++i) { const int idx = tid + 512 * i, kk = idx >> 6, nn = idx & 63, n = n0 + nn;
        const float* W = W0; int src = n;
        if (mode == 1) src = win_src(n);
        else if (mode == 2) { const int pn = n >> 8, c = n & 255; if (c >= 128) W = W1; src = pn * 128 + (c & 127); }
        float v = W[(size_t)(k0 + kk) * ldw + src]; if (gk) v *= gk[k0 + kk];
        scr[kk * 65 + nn] = v; }
    __syncthreads();
    { const int nn = tid >> 3, kg = (tid & 7) * 8;
        u32x4 o; o.x = cvtpk(scr[(kg + 0) * 65 + nn], scr[(kg + 1) * 65 + nn]); o.y = cvtpk(scr[(kg + 2) * 65 + nn], scr[(kg + 3) * 65 + nn]);
        o.z = cvtpk(scr[(kg + 4) * 65 + nn], scr[(kg + 5) * 65 + nn]); o.w = cvtpk(scr[(kg + 6) * 65 + nn], scr[(kg + 7) * 65 + nn]);
        *(u32x4*)(Bt + (size_t)(n0 + nn) * K + k0 + kg) = o; }
    __syncthreads();
}

DI void p0_prep(const Params& p, LAS unsigned char* lds) {
    const int tid = launder_tid(), lane = tid & 63, wid = tid >> 6, G = gridDim.x, bid = blockIdx.x;
    unsigned char* ws = p.ws;
    LAS float* scr = (LAS float*)lds;
    constexpr int T_IN = 16 * 48, T_OUT = 16 * 16, T_GU = 16 * 88, T_DN = 44 * 16;
    for (int it = bid; it < T_IN + T_OUT + T_GU + T_DN; it += G) {
        if (it < T_IN) { const int kt = it / 48, nt = it % 48; p0_transpose_tile(p.w_in, nullptr, PIN, DM, p.g_mix, (bf16_t*)(ws + WS_WIN), 1, kt * 64, nt * 64, scr); }
        else if (it < T_IN + T_OUT) { const int j = it - T_IN, kt = j / 16, nt = j % 16; p0_transpose_tile(p.w_out, nullptr, DM, DM, nullptr, (bf16_t*)(ws + WS_WOUT), 0, kt * 64, nt * 64, scr); }
        else if (it < T_IN + T_OUT + T_GU) { const int j = it - T_IN - T_OUT, kt = j / 88, nt = j % 88; p0_transpose_tile(p.w_gate, p.w_up, DFF, DM, p.g_ffn, (bf16_t*)(ws + WS_WGU), 2, kt * 64, nt * 64, scr); }
        else { const int j = it - T_IN - T_OUT - T_GU, kt = j / 16, nt = j % 16; p0_transpose_tile(p.w_down, nullptr, DM, DFF, nullptr, (bf16_t*)(ws + WS_WDN), 0, kt * 64, nt * 64, scr); }
    }
    bf16_t* XN = (bf16_t*)(ws + WS_XN);
    for (int row0 = (bid * 8 + wid) * 4; row0 < ROW_M + NMETA; row0 += G * 32) {
        f32x4 v[4][4];
#pragma unroll
        for (int j = 0; j < 4; ++j) { const int row = row0 + j < ROW_M + NMETA ? row0 + j : ROW_M + NMETA - 1;
            const float* xr = row < ROW_S ? p.x_prompt + (size_t)row * DM : row < ROW_M ? p.x_sample + (size_t)(row - ROW_S) * DM : p.meta + (size_t)(row - ROW_M) * DM;
            v[j][0] = __builtin_nontemporal_load((const f32x4*)(xr + lane * 8)); v[j][1] = __builtin_nontemporal_load((const f32x4*)(xr + lane * 8 + 4));
            v[j][2] = __builtin_nontemporal_load((const f32x4*)(xr + 512 + lane * 8)); v[j][3] = __builtin_nontemporal_load((const f32x4*)(xr + 512 + lane * 8 + 4)); }
#pragma unroll
        for (int j = 0; j < 4; ++j) { const int row = row0 + j; if (row >= ROW_M + NMETA) break;
            float ss = 0.f;
#pragma unroll
            for (int q = 0; q < 4; ++q)
#pragma unroll
                for (int i = 0; i < 4; ++i) ss += v[j][q][i] * v[j][q][i];
            ss = wave_sum(ss);
            const float r = rsqrtf(ss * (1.0f / DM) + EPS);
            if (lane == 0 && row < ROW_M) ((float*)(ws + WS_RINV))[row] = sqrtf(ss * (1.0f / DM) + EPS);
            u32x4 o0, o1;
            o0.x = cvtpk(v[j][0][0] * r, v[j][0][1] * r); o0.y = cvtpk(v[j][0][2] * r, v[j][0][3] * r); o0.z = cvtpk(v[j][1][0] * r, v[j][1][1] * r); o0.w = cvtpk(v[j][1][2] * r, v[j][1][3] * r);
            o1.x = cvtpk(v[j][2][0] * r, v[j][2][1] * r); o1.y = cvtpk(v[j][2][2] * r, v[j][2][3] * r); o1.z = cvtpk(v[j][3][0] * r, v[j][3][1] * r); o1.w = cvtpk(v[j][3][2] * r, v[j][3][3] * r);
            *(u32x4*)(XN + (size_t)row * DM + lane * 8) = o0; *(u32x4*)(XN + (size_t)row * DM + 512 + lane * 8) = o1; }
    }
    for (int i = bid * 512 + tid; i < 2 * 48 * 64; i += G * 512) { const int which = i / (48 * 64), j = i % (48 * 64);
        *(u32x4*)((bf16_t*)(ws + (which ? WS_VB : WS_KB)) + (size_t)(ROW_M + NMETA) * 512 + (size_t)j * 8) = (u32x4){0u, 0u, 0u, 0u}; }
}

struct EpiIn {
    static constexpr bool PERM = true, AFTER_DRAIN = false;
    const float *gq, *gk; unsigned char* ws; float* out;
    DI void operator()(const f32x4 (&acc)[2][2][4][2], const Unit& u, int wr, int wc, int fr, int fq) const {
        const int pn = u.pn, pm = u.pm;
        const int kind = pm < 256 ? 0 : pm < 260 ? 1 : 2;
        if (pn < 4) {
            const bool isk = pn >= 2; const float* g = isk ? gk : gq;
            const int head = 2 * (pn & 1) + (wc >> 1), cmp = wc & 1;
            f32x4 gv[2][2];
#pragma unroll
            for (int bj = 0; bj < 2; ++bj)
#pragma unroll
                for (int n = 0; n < 2; ++n) gv[bj][n] = *(const f32x4*)(g + 32 * bj + 8 * fq + 4 * n);
            const float sgn = fq == 0 ? -1.f : 1.f; const float qs = isk ? 1.f : 0.18033688011112042f;
            float invr[2][4];
#pragma unroll
            for (int n = 0; n < 2; ++n)
#pragma unroll
                for (int t4 = 0; t4 < 4; ++t4) invr[n][t4] = exp2f(-(float)(4 * n + t4) * (18.931568569324174f / 8.0f)) * 0.15915494309189535f;
#pragma unroll
            for (int ai = 0; ai < 2; ++ai)
#pragma unroll
                for (int m = 0; m < 4; ++m) {
                    const int row = pm * 256 + 128 * ai + 64 * wr + 16 * m + fr;
                    int b, t, pos; bool valid = true;
                    if (kind == 0) { b = row >> 12; t = row & 4095; pos = NMETA + t; } else if (kind == 1) { const int rs = row - ROW_S; b = rs >> 6; t = rs & 63; pos = LCACHE + t; } else { b = 0; t = row - ROW_M; pos = t; valid = t < NMETA; if (!valid) pos = 0; }
                    f32x4 v[2][2]; float ss = 0.f;
#pragma unroll
                    for (int bj = 0; bj < 2; ++bj)
#pragma unroll
                        for (int n = 0; n < 2; ++n) { v[bj][n] = acc[ai][bj][m][n]; ss += v[bj][n][0] * v[bj][n][0] + v[bj][n][1] * v[bj][n][1] + v[bj][n][2] * v[bj][n][2] + v[bj][n][3] * v[bj][n][3]; }
                    ss += shx(ss, 16); ss += shx(ss, 32);
                    const float r = rsqrtf(ss * (1.0f / 64.f) + EPS);
#pragma unroll
                    for (int bj = 0; bj < 2; ++bj)
#pragma unroll
                        for (int n = 0; n < 2; ++n) v[bj][n] = v[bj][n] * r * gv[bj][n];
                    f32x4 pr[2];
#pragma unroll
                    for (int n = 0; n < 2; ++n)
#pragma unroll
                        for (int t4 = 0; t4 < 4; ++t4) pr[n][t4] = shx(v[0][n][t4], 16);
                    if (fq < 2) {
                        const float pf_ = (float)pos;
#pragma unroll
                        for (int n = 0; n < 2; ++n)
#pragma unroll
                            for (int t4 = 0; t4 < 4; ++t4) { const float rev = __builtin_amdgcn_fractf(pf_ * invr[n][t4]);
                                const float cs = __builtin_amdgcn_cosf(rev), sn = __builtin_amdgcn_sinf(rev);
                                v[0][n][t4] = v[0][n][t4] * cs + sgn * pr[n][t4] * sn; }
                    }
                    if (!valid) continue;
                    const int cb = head * 128 + cmp * 64 + 8 * fq;
#pragma unroll
                    for (int bj = 0; bj < 2; ++bj) {
                        u32x4 w; w.x = cvtpk(v[bj][0][0] * qs, v[bj][0][1] * qs); w.y = cvtpk(v[bj][0][2] * qs, v[bj][0][3] * qs); w.z = cvtpk(v[bj][1][0] * qs, v[bj][1][1] * qs); w.w = cvtpk(v[bj][1][2] * qs, v[bj][1][3] * qs);
                        __builtin_nontemporal_store(w, (u32x4*)((bf16_t*)(ws + (isk ? WS_KB : WS_QB)) + (size_t)row * 512 + cb + 32 * bj));
                    }
                    if (isk) {
                        if (kind == 0) { float* o = out + O_KP + ((size_t)(b * LCACHE + NMETA + t)) * 512 + cb;
#pragma unroll
                            for (int bj = 0; bj < 2; ++bj) { __builtin_nontemporal_store(v[bj][0], (f32x4*)(o + 32 * bj)); __builtin_nontemporal_store(v[bj][1], (f32x4*)(o + 32 * bj + 4)); } }
                        else if (kind == 1) { float* o = out + O_KS + ((size_t)(b * DSEQ + t)) * 512 + cb;
#pragma unroll
                            for (int bj = 0; bj < 2; ++bj) { __builtin_nontemporal_store(v[bj][0], (f32x4*)(o + 32 * bj)); __builtin_nontemporal_store(v[bj][1], (f32x4*)(o + 32 * bj + 4)); } }
                        else { for (int b2 = 0; b2 < NB; ++b2) { float* o = out + O_KP + ((size_t)(b2 * LCACHE + t)) * 512 + cb;
#pragma unroll
                                for (int bj = 0; bj < 2; ++bj) { __builtin_nontemporal_store(v[bj][0], (f32x4*)(o + 32 * bj)); __builtin_nontemporal_store(v[bj][1], (f32x4*)(o + 32 * bj + 4)); } } }
                    }
                }
        } else if (pn == 6 || pn == 7) {
            const bool isk = pn == 7; const float sc = isk ? 0.125f : 1.f; const int head = wc;
            float invr[2][4];
#pragma unroll
            for (int n = 0; n < 2; ++n)
#pragma unroll
                for (int t4 = 0; t4 < 4; ++t4) invr[n][t4] = exp2f(-(float)(8 * fq + 4 * n + t4) * (13.287712379549449f / 32.0f)) * 0.15915494309189535f;
#pragma unroll
            for (int ai = 0; ai < 2; ++ai)
#pragma unroll
                for (int m = 0; m < 4; ++m) {
                    const int row = pm * 256 + 128 * ai + 64 * wr + 16 * m + fr;
                    int pos; bool valid = true;
                    if (kind == 0) pos = NMETA + (row & 4095); else if (kind == 1) pos = LCACHE + ((row - ROW_S) & 63); else { pos = row - ROW_M; valid = pos < NMETA; if (!valid) pos = 0; }
                    f32x4 o1[2], o2[2];
                    const float pf_ = (float)pos;
#pragma unroll
                    for (int n = 0; n < 2; ++n) { const f32x4 x1 = acc[ai][0][m][n], x2 = acc[ai][1][m][n];
#pragma unroll
                        for (int t4 = 0; t4 < 4; ++t4) { const float rev = __builtin_amdgcn_fractf(pf_ * invr[n][t4]);
                            const float cs = __builtin_amdgcn_cosf(rev), sn = __builtin_amdgcn_sinf(rev);
                            o1[n][t4] = (x1[t4] * cs - x2[t4] * sn) * sc; o2[n][t4] = (x2[t4] * cs + x1[t4] * sn) * sc; } }
                    if (!valid) continue;
                    bf16_t* d = (bf16_t*)(ws + (isk ? WS_RKB : WS_RQB)) + (size_t)row * 256 + head * 64 + 8 * fq;
                    u32x4 w; w.x = cvtpk(o1[0][0], o1[0][1]); w.y = cvtpk(o1[0][2], o1[0][3]); w.z = cvtpk(o1[1][0], o1[1][1]); w.w = cvtpk(o1[1][2], o1[1][3]); *(u32x4*)d = w;
                    w.x = cvtpk(o2[0][0], o2[0][1]); w.y = cvtpk(o2[0][2], o2[0][3]); w.z = cvtpk(o2[1][0], o2[1][1]); w.w = cvtpk(o2[1][2], o2[1][3]); *(u32x4*)(d + 32) = w;
                }
        } else {
            bf16_t* base; int colt; bool isv = false;
            if (pn < 6) { base = (bf16_t*)(ws + WS_VB); colt = (pn - 4) * 256; isv = true; } else if (pn < 10) { base = (bf16_t*)(ws + WS_RVB); colt = (pn - 8) * 256; } else { base = (bf16_t*)(ws + WS_RGB); colt = (pn - 10) * 256; }
#pragma unroll
            for (int ai = 0; ai < 2; ++ai)
#pragma unroll
                for (int m = 0; m < 4; ++m) {
                    const int row = pm * 256 + 128 * ai + 64 * wr + 16 * m + fr;
                    int b, t; bool valid = true;
                    if (kind == 0) { b = row >> 12; t = row & 4095; } else if (kind == 1) { const int rs = row - ROW_S; b = rs >> 6; t = rs & 63; } else { b = 0; t = row - ROW_M; valid = t < NMETA; }
                    if (!valid) continue;
#pragma unroll
                    for (int bj = 0; bj < 2; ++bj) {
                        const int col = colt + 128 * bj + 32 * wc + 8 * fq;
                        const f32x4 v0 = acc[ai][bj][m][0], v1 = acc[ai][bj][m][1];
                        u32x4 w; w.x = cvtpk(v0[0], v0[1]); w.y = cvtpk(v0[2], v0[3]); w.z = cvtpk(v1[0], v1[1]); w.w = cvtpk(v1[2], v1[3]);
                        __builtin_nontemporal_store(w, (u32x4*)(base + (size_t)row * 512 + col));
                        if (isv) {
                            if (kind == 0) { float* o = out + O_VP + ((size_t)(b * LCACHE + NMETA + t)) * 512 + col; __builtin_nontemporal_store(v0, (f32x4*)o); __builtin_nontemporal_store(v1, (f32x4*)(o + 4)); }
                            else if (kind == 1) { float* o = out + O_VS + ((size_t)(b * DSEQ + t)) * 512 + col; __builtin_nontemporal_store(v0, (f32x4*)o); __builtin_nontemporal_store(v1, (f32x4*)(o + 4)); }
                            else { for (int b2 = 0; b2 < NB; ++b2) { float* o = out + O_VP + ((size_t)(b2 * LCACHE + t)) * 512 + col; __builtin_nontemporal_store(v0, (f32x4*)o); __builtin_nontemporal_store(v1, (f32x4*)(o + 4)); } }
                        }
                    }
                }
        }
    }
};

struct EpiOut {
    static constexpr bool PERM = true, AFTER_DRAIN = false;
    const float* rinv; bf16_t* HB; float* SSQ;
    DI void operator()(const f32x4 (&acc)[2][2][4][2], const Unit& u, int wr, int wc, int fr, int fq) const {
#pragma unroll
        for (int ai = 0; ai < 2; ++ai)
#pragma unroll
            for (int m = 0; m < 4; ++m) {
                const int row = u.pm * 256 + 128 * ai + 64 * wr + 16 * m + fr;
                const float ri = rinv[row];
                float ss = 0.f;
#pragma unroll
                for (int bj = 0; bj < 2; ++bj) {
                    const int col = u.pn * 256 + 128 * bj + 32 * wc + 8 * fq;
                    const u32x4 xb = *(const u32x4*)(HB + (size_t)row * DM + col);
                    f32x4 v0 = acc[ai][bj][m][0], v1 = acc[ai][bj][m][1];
                    v0[0] += bflo(xb.x) * ri; v0[1] += bfhi(xb.x) * ri; v0[2] += bflo(xb.y) * ri; v0[3] += bfhi(xb.y) * ri;
                    v1[0] += bflo(xb.z) * ri; v1[1] += bfhi(xb.z) * ri; v1[2] += bflo(xb.w) * ri; v1[3] += bfhi(xb.w) * ri;
                    u32x4 w; w.x = cvtpk(v0[0], v0[1]); w.y = cvtpk(v0[2], v0[3]); w.z = cvtpk(v1[0], v1[1]); w.w = cvtpk(v1[2], v1[3]);
                    __builtin_nontemporal_store(w, (u32x4*)(HB + (size_t)row * DM + col));
#pragma unroll
                    for (int i = 0; i < 4; ++i) ss += v0[i] * v0[i] + v1[i] * v1[i];
                }
                ss += shx(ss, 16); ss += shx(ss, 32);
                if (fq == 0) SSQ[(size_t)row * 16 + u.pn * 4 + wc] = ss;
            }
    }
};

struct EpiGU {
    static constexpr bool PERM = true, AFTER_DRAIN = false;
    const float* SSQ; bf16_t* ACT;
    DI void operator()(const f32x4 (&acc)[2][2][4][2], const Unit& u, int wr, int wc, int fr, int fq) const {
#pragma unroll
        for (int ai = 0; ai < 2; ++ai)
#pragma unroll
            for (int m = 0; m < 4; ++m) {
                const int row = u.pm * 256 + 128 * ai + 64 * wr + 16 * m + fr;
                const float* sp = SSQ + (size_t)row * 16;
                const f32x4 s0 = *(const f32x4*)sp, s1 = *(const f32x4*)(sp + 4), s2 = *(const f32x4*)(sp + 8), s3 = *(const f32x4*)(sp + 12);
                float ss = 0.f;
#pragma unroll
                for (int i = 0; i < 4; ++i) ss += s0[i] + s1[i] + s2[i] + s3[i];
                const float rs = rsqrtf(ss * (1.0f / DM) + EPS);
                float a[8];
#pragma unroll
                for (int n = 0; n < 2; ++n)
#pragma unroll
                    for (int t = 0; t < 4; ++t) a[4 * n + t] = silu_f(acc[ai][0][m][n][t] * rs) * (acc[ai][1][m][n][t] * rs);
                u32x4 w; w.x = cvtpk(a[0], a[1]); w.y = cvtpk(a[2], a[3]); w.z = cvtpk(a[4], a[5]); w.w = cvtpk(a[6], a[7]);
                __builtin_nontemporal_store(w, (u32x4*)(ACT + (size_t)row * DFF + u.pn * 128 + 32 * wc + 8 * fq));
            }
    }
};

struct EpiDown {
    static constexpr bool PERM = true, AFTER_DRAIN = false;
    float* out; const bf16_t* HB; LAS unsigned char* lstage;
    DI void operator()(const f32x4 (&acc)[2][2][4][2], const Unit& u, int wr, int wc, int fr, int fq) const {
        LAS unsigned char* st = lstage + (wr * 4 + wc) * 4096;
#pragma unroll
        for (int ai = 0; ai < 2; ++ai)
#pragma unroll
            for (int m = 0; m < 4; ++m) {
                const int row0g = u.pm * 256 + 128 * ai + 64 * wr + 16 * m, row = row0g + fr;
#pragma unroll
                for (int bj = 0; bj < 2; ++bj) {
                    const size_t idx = (size_t)row * DM + u.pn * 256 + 128 * bj + 32 * wc + 8 * fq;
                    const u32x4 hb = *(const u32x4*)(HB + idx);
                    f32x4 v0 = acc[ai][bj][m][0], v1 = acc[ai][bj][m][1];
                    v0[0] += bflo(hb.x); v0[1] += bfhi(hb.x); v0[2] += bflo(hb.y); v0[3] += bfhi(hb.y); v1[0] += bflo(hb.z); v1[1] += bfhi(hb.z); v1[2] += bflo(hb.w); v1[3] += bfhi(hb.w);
                    *(LAS f32x4*)(st + fr * 256 + (((bj * 8 + fq * 2) ^ fr) << 4)) = v0; *(LAS f32x4*)(st + fr * 256 + (((bj * 8 + fq * 2 + 1) ^ fr) << 4)) = v1;
                }
                float* ob = out + (size_t)row0g * DM + u.pn * 256 + 128 * (fr >> 3) + 32 * wc + (fr & 7) * 4;
#pragma unroll
                for (int j = 0; j < 4; ++j) { const int rr = 4 * j + fq; const f32x4 d = *(const LAS f32x4*)(st + rr * 256 + ((fr ^ rr) << 4));
                    __builtin_nontemporal_store(d, (f32x4*)(ob + (size_t)rr * DM)); }
            }
    }
};

constexpr int KRS = 272, VRS = 320;
constexpr int SLOT_B = 64 * KRS + 64 * VRS;
constexpr int SLOT_V = 64 * KRS;

DI void stage_tile(LAS char* slot, const bf16_t* Kg, const bf16_t* Vg, int nvalid, int tid) {
#pragma unroll
    for (int j = 0; j < 2; ++j) { const int pc = tid + 512 * j, r = pc >> 4, c16 = pc & 15;
        u32x4 kv = {0u, 0u, 0u, 0u}, vv = {0u, 0u, 0u, 0u};
        if (r < nvalid) { kv = *(const u32x4*)(Kg + (size_t)r * 512 + c16 * 8); vv = *(const u32x4*)(Vg + (size_t)r * 512 + c16 * 8); }
        *(LAS u32x4*)(slot + r * KRS + c16 * 16) = kv; *(LAS u32x4*)(slot + SLOT_V + r * VRS + c16 * 16) = vv; }
}

DI void dma_offsets(unsigned (&poff)[5], int wid, int lane) {
#pragma unroll
    for (int j = 0; j < 5; ++j) { const int g0 = wid * 5 + j, gi = g0 > 36 ? 36 : g0; unsigned off = 0;
        if (gi < 17) { const int sidx = gi * 64 + lane, row = sidx / 17, c = sidx - row * 17; off = (unsigned)(row << 10) | (unsigned)((c > 15 ? 15 : c) << 4); }
        else if (gi < 37) { const int sidx = (gi - 17) * 64 + lane, row = sidx / 20, c = sidx - row * 20; off = (unsigned)(row << 10) | (unsigned)((c > 15 ? 15 : c) << 4); }
        poff[j] = off; }
}
DI void glds16(const void* gbase, unsigned voff, unsigned lds_dst) { unsigned keep;
    asm volatile("s_mov_b32 %0, m0\n\ts_mov_b32 m0, %3\n\ts_nop 0\n\tglobal_load_lds_dwordx4 %1, %2\n\ts_mov_b32 m0, %0" : "=&s"(keep) : "v"(voff), "s"(gbase), "s"(lds_dst) : "memory"); }
DI void dma_tile(LAS char* slot, const bf16_t* Kg, const bf16_t* Vg, const unsigned (&poff)[5], int wid) {
#pragma unroll
    for (int j = 0; j < 5; ++j) { const int g0 = wid * 5 + j, gi = g0 > 36 ? 36 : g0;
        { const bool isk = gi < 17; glds16(isk ? (const void*)Kg : (const void*)Vg, poff[j], (unsigned)(size_t)(isk ? slot + gi * 1024 : slot + SLOT_V + (gi - 17) * 1024)); } }
}

#define SGB(mask, n) __builtin_amdgcn_sched_group_barrier((mask), (n), 0)
DI void attn_qk(const LAS char* kb, const bf16x8 (&qf)[4], bf16x8 (&pf)[4], float& l) {
    f32x16 zero;
#pragma unroll
    for (int i = 0; i < 16; ++i) zero[i] = 0.f;
    bf16x8 k0[4], k1[4];
#pragma unroll
    for (int s = 0; s < 4; ++s) k0[s] = *(const LAS bf16x8*)(kb + 32 * s);
#pragma unroll
    for (int s = 0; s < 4; ++s) k1[s] = *(const LAS bf16x8*)(kb + 32 * KRS + 32 * s);
    f32x16 st0 = MFMA32(k0[0], qf[0], zero), st1 = MFMA32(k1[0], qf[0], zero);
#pragma unroll
    for (int s = 1; s < 4; ++s) { st0 = MFMA32(k0[s], qf[s], st0); st1 = MFMA32(k1[s], qf[s], st1); }
    SGB(0x100, 8); SGB(0x008, 8);
    float sum = 0.f;
#pragma unroll
    for (int i = 0; i < 16; ++i) { const float e = __builtin_amdgcn_exp2f(st0[i]); st0[i] = e; sum += e; }
    pf[0] = pack8(st0, 0); pf[1] = pack8(st0, 1);
#pragma unroll
    for (int i = 0; i < 16; ++i) { const float e = __builtin_amdgcn_exp2f(st1[i]); st1[i] = e; sum += e; }
    pf[2] = pack8(st1, 0); pf[3] = pack8(st1, 1);
    l += sum;
}
DI void attn_pv(const LAS char* vb, const bf16x8 (&pf)[4], f32x16 (&O)[4]) {
    s16x4 va[8], vc[8];
#pragma unroll
    for (int ks = 0; ks < 4; ++ks) { va[2 * ks] = vtr(vb + ks * 16 * VRS); va[2 * ks + 1] = vtr(vb + (ks * 16 + 8) * VRS); }
#pragma unroll
    for (int ks = 0; ks < 4; ++ks) { vc[2 * ks] = vtr(vb + ks * 16 * VRS + 64); vc[2 * ks + 1] = vtr(vb + (ks * 16 + 8) * VRS + 64); }
#pragma unroll
    for (int ks = 0; ks < 4; ++ks) O[0] = MFMA32(cat4(va[2 * ks], va[2 * ks + 1]), pf[ks], O[0]);
#pragma unroll
    for (int ks = 0; ks < 4; ++ks) { va[2 * ks] = vtr(vb + ks * 16 * VRS + 128); va[2 * ks + 1] = vtr(vb + (ks * 16 + 8) * VRS + 128); }
    SGB(0x100, 16); SGB(0x008, 4); SGB(0x100, 8);
#pragma unroll
    for (int ks = 0; ks < 4; ++ks) O[1] = MFMA32(cat4(vc[2 * ks], vc[2 * ks + 1]), pf[ks], O[1]);
#pragma unroll
    for (int ks = 0; ks < 4; ++ks) { vc[2 * ks] = vtr(vb + ks * 16 * VRS + 192); vc[2 * ks + 1] = vtr(vb + (ks * 16 + 8) * VRS + 192); }
    SGB(0x008, 4); SGB(0x100, 8);
#pragma unroll
    for (int ks = 0; ks < 4; ++ks) O[2] = MFMA32(cat4(va[2 * ks], va[2 * ks + 1]), pf[ks], O[2]);
    SGB(0x008, 4);
#pragma unroll
    for (int ks = 0; ks < 4; ++ks) O[3] = MFMA32(cat4(vc[2 * ks], vc[2 * ks + 1]), pf[ks], O[3]);
    SGB(0x008, 4);
}

constexpr int BUF_B = 2 * SLOT_B;
DI void attn_unit(const Params& p, LAS unsigned char* ldsu, int kind, int b, int h, int u, float lam) {
    LAS char* lds = (LAS char*)ldsu;
    const int tid = launder_tid(), lane = tid & 63, wid = __builtin_amdgcn_readfirstlane(tid >> 6), qr = lane & 31, hh = lane >> 5;
    const int cmp = wid >> 2, r = wid & 3;
    unsigned char* ws = p.ws;
    const bf16_t* KB = (const bf16_t*)(ws + WS_KB); const bf16_t* VB = (const bf16_t*)(ws + WS_VB);
    const int hc = h * 128;
    int qrow, my_last, nsteps, ntl;
    if (kind == 0) { qrow = b * SEQ + u * 128 + 32 * r; my_last = 2 * u + (r >> 1) + 1; ntl = 2 * u + 3; nsteps = 0; }
    else { qrow = ROW_S + b * DSEQ + 32 * (r & 1); my_last = r < 2 ? 65 : -1; ntl = 66; nsteps = 0; }
    (void)nsteps;
    bf16x8 qf[4];
    { const bf16_t* qp = (const bf16_t*)(ws + WS_QB) + (size_t)(qrow + qr) * 512 + hc + cmp * 64 + 8 * hh;
#pragma unroll
        for (int s = 0; s < 4; ++s) qf[s] = *(const bf16x8*)(qp + 16 * s); }
    f32x16 O[4]; float l = 0.f;
#pragma unroll
    for (int v = 0; v < 4; ++v)
#pragma unroll
        for (int i = 0; i < 16; ++i) O[v][i] = 0.f;
    const int i16 = lane & 15, q4 = i16 >> 2, p4 = i16 & 3, blk = (lane >> 4) & 1;
    const int kboff = qr * KRS + 16 * hh + cmp * 128, vboff = SLOT_V + (4 * hh + q4) * VRS + blk * 32 + p4 * 8;
#define BAR_LANDED() asm volatile("s_waitcnt vmcnt(10)\n\ts_barrier" ::: "memory")
    if (kind == 0) {
        unsigned poff[5]; dma_offsets(poff, wid, lane);
        auto stage = [&](int t) { if (t >= ntl) t = ntl - 1; const int row0 = t == 0 ? ROW_M : b * SEQ + (t - 1) * 64;
            dma_tile(lds + (t & 3) * SLOT_B, KB + (size_t)row0 * 512 + hc, VB + (size_t)row0 * 512 + hc, poff, wid); };
        stage(0); stage(1); stage(2);
        asm volatile("s_waitcnt vmcnt(10)" ::: "memory");
        __syncthreads();
        for (int t = 0; t < ntl; ++t) {
            stage(t + 3);
            const LAS char* sp = lds + (t & 3) * SLOT_B;
            if (t <= my_last) { bf16x8 pf[4]; attn_qk(sp + kboff, qf, pf, l); attn_pv(sp + vboff, pf, O); }
            BAR_LANDED();
        }
    } else {
        f32x4 kr[4], vr[4];
        auto ld = [&](int t) {
            const float *ks, *vs; int nv = 64;
            if (t == 0) { ks = p.cache_k + ((size_t)b * LCACHE + 4096) * 512 + hc; vs = p.cache_v + ((size_t)b * LCACHE + 4096) * 512 + hc; nv = 16; }
            else if (t < 65) { ks = p.cache_k + ((size_t)b * LCACHE + 64 * (t - 1)) * 512 + hc; vs = p.cache_v + ((size_t)b * LCACHE + 64 * (t - 1)) * 512 + hc; }
            else { ks = p.out + O_KS + (size_t)b * DSEQ * 512 + hc; vs = p.out + O_VS + (size_t)b * DSEQ * 512 + hc; }
#pragma unroll
            for (int j = 0; j < 4; ++j) { const int pc = tid + 512 * j, rr = pc >> 5, c4 = pc & 31;
                kr[j] = (f32x4){0.f, 0.f, 0.f, 0.f}; vr[j] = (f32x4){0.f, 0.f, 0.f, 0.f};
                if (rr < nv) { kr[j] = *(const f32x4*)(ks + (size_t)rr * 512 + c4 * 4); vr[j] = *(const f32x4*)(vs + (size_t)rr * 512 + c4 * 4); } }
        };
        auto st = [&](int t) { LAS char* sp = lds + (t & 1) * SLOT_B;
#pragma unroll
            for (int j = 0; j < 4; ++j) { const int pc = tid + 512 * j, rr = pc >> 5, c4 = pc & 31;
                u32x2 kw, vw; kw.x = cvtpk(kr[j][0], kr[j][1]); kw.y = cvtpk(kr[j][2], kr[j][3]); vw.x = cvtpk(vr[j][0], vr[j][1]); vw.y = cvtpk(vr[j][2], vr[j][3]);
                *(LAS u32x2*)(sp + rr * KRS + c4 * 8) = kw; *(LAS u32x2*)(sp + SLOT_V + rr * VRS + c4 * 8) = vw; } };
        ld(0); st(0); ld(1);
        __syncthreads();
        for (int t = 0; t < ntl; ++t) {
            const LAS char* sp = lds + (t & 1) * SLOT_B;
            if (t <= my_last) { bf16x8 pf[4]; attn_qk(sp + kboff, qf, pf, l); attn_pv(sp + vboff, pf, O); }
            if (t + 1 < ntl) st(t + 1);
            if (t + 2 < ntl) ld(t + 2);
            asm volatile("s_waitcnt lgkmcnt(0)\n\ts_barrier" ::: "memory");
        }
    }
    asm volatile("s_waitcnt vmcnt(0)" ::: "memory");
    __syncthreads();
    const float lt = l + shx(l, 32) - 48.f;
    LAS float* xch = (LAS float*)lds + r * 4096 + lane;
    if (cmp == 1) { const float sc = lam / lt;
#pragma unroll
        for (int v = 0; v < 4; ++v)
#pragma unroll
            for (int i = 0; i < 16; ++i) xch[(v * 16 + i) * 64] = O[v][i] * sc; }
    __syncthreads();
    if (cmp == 0 && my_last >= 0) {
        const float i0 = 1.0f / lt; float ss = 0.f;
#pragma unroll
        for (int v = 0; v < 4; ++v)
#pragma unroll
            for (int i = 0; i < 16; ++i) { const float o = O[v][i] * i0 - xch[(v * 16 + i) * 64]; O[v][i] = o; ss += o * o; }
        ss += shx(ss, 32);
        const float rn = rsqrtf(ss * (1.0f / 128.f) + EPS) * 0.8f;
        LAS char* ost = lds + 65536 + r * (32 * KRS);
#pragma unroll
        for (int v = 0; v < 4; ++v)
#pragma unroll
            for (int g4 = 0; g4 < 4; ++g4) { const int vd = v * 32 + 8 * g4 + 4 * hh; const f32x4 gs = *(const f32x4*)(p.g_sub + vd);
                u32x2 w; w.x = cvtpk(O[v][4 * g4] * rn * gs[0], O[v][4 * g4 + 1] * rn * gs[1]); w.y = cvtpk(O[v][4 * g4 + 2] * rn * gs[2], O[v][4 * g4 + 3] * rn * gs[3]);
                *(LAS u32x2*)(ost + qr * KRS + vd * 2) = w; }
        bf16_t* dst = (bf16_t*)(ws + WS_MIX) + (size_t)qrow * DM + hc;
#pragma unroll
        for (int j = 0; j < 8; ++j) { const int pc = lane + 64 * j, row = pc >> 4, c16 = pc & 15;
            const u32x4 d = *(const LAS u32x4*)(ost + row * KRS + c16 * 16);
            *(u32x4*)(dst + (size_t)row * DM + c16 * 8) = d; }
    }
}

constexpr int QRS = 144;
constexpr int RG_B = 2 * 64 * QRS + 64 * VRS;
DI void ret_unit(const Params& p, LAS unsigned char* ldsu, int mode, int b, int hp, int seg) {
    LAS char* lds = (LAS char*)ldsu;
    const int tid = launder_tid(), lane = tid & 63, wid = __builtin_amdgcn_readfirstlane(tid >> 6), qr = lane & 31, hh = lane >> 5;
    const int g = wid >> 2, wq = wid & 3, h = 2 * hp + g, vs = wq * 32, gt = tid & 255;
    unsigned char* ws = p.ws;
    const bf16_t* RQB = (const bf16_t*)(ws + WS_RQB); const bf16_t* RKB = (const bf16_t*)(ws + WS_RKB); const bf16_t* RVB = (const bf16_t*)(ws + WS_RVB); const bf16_t* RGB = (const bf16_t*)(ws + WS_RGB);
    bf16_t* MIX = (bf16_t*)(ws + WS_MIX);
    LAS char* Lq = lds + g * RG_B; LAS char* Lk = Lq + 64 * QRS; LAS char* Lv = Lk + 64 * QRS;
    LAS float* red = (LAS float*)(lds + 2 * RG_B) + g * 256;
    const float lg2 = log2f(1.0f - exp2f(-5.0f - (float)h));
    unsigned* flags = (unsigned*)(ws + WS_CTL) + 1024 + (b * 2 + hp) * 8;
    float* Tb = (float*)(ws + WS_T) + ((size_t)(b * 4 + h) * 8) * 8192 + vs + qr;
    f32x16 S[2];
#pragma unroll
    for (int ks = 0; ks < 2; ++ks)
#pragma unroll
        for (int i = 0; i < 16; ++i) S[ks][i] = 0.f;
    if (mode == 2) { const float* sin_ = p.state_ret + ((size_t)(b * 4 + h) * 64) * 128 + vs + qr;
#pragma unroll
        for (int ks = 0; ks < 2; ++ks)
#pragma unroll
            for (int i = 0; i < 16; ++i) S[ks][i] = sin_[(size_t)(32 * ks + crow(i, hh)) * 128]; }
    else if (mode == 1 && seg > 0) {
        if (tid == 0) { for (int sp = 0; sp < seg; ++sp) while (__hip_atomic_load(flags + sp, __ATOMIC_RELAXED, __HIP_MEMORY_SCOPE_AGENT) == 0u) __builtin_amdgcn_s_sleep(2);
            __builtin_amdgcn_fence(__ATOMIC_ACQUIRE, "agent"); asm volatile("s_waitcnt vmcnt(0)" ::: "memory"); }
        __syncthreads();
        for (int sp = 0; sp < seg; ++sp) { const float w = exp2f(512.f * (float)(seg - 1 - sp) * lg2); const float* tp = Tb + (size_t)sp * 8192;
#pragma unroll
            for (int ks = 0; ks < 2; ++ks)
#pragma unroll
                for (int i = 0; i < 16; ++i) S[ks][i] += w * __builtin_nontemporal_load(tp + (size_t)(32 * ks + crow(i, hh)) * 128); }
    }
    const int nch = mode == 2 ? 1 : (seg == 0 ? 9 : 8);
    const int i16 = lane & 15, q4 = i16 >> 2, p4 = i16 & 3, blk = (lane >> 4) & 1, qmh = qr - 4 * hh;
    auto geom = [&](int ci, int& row0, int& C, bool& so) { C = 64; so = mode == 0;
        if (mode == 2) row0 = ROW_S + b * DSEQ;
        else if (seg == 0) { if (ci == 0) { row0 = ROW_M; C = NMETA; so = true; } else row0 = b * SEQ + (ci - 1) * 64; }
        else row0 = b * SEQ + (8 * seg + ci) * 64; };
    u32x4 pq[2], pk[2], pv[4];
    auto gload = [&](int ci) { int row0, C; bool so; geom(ci, row0, C, so);
#pragma unroll
        for (int j = 0; j < 2; ++j) { const int pc = gt + 256 * j, r = pc >> 3, c8 = pc & 7; pq[j] = (u32x4){0u, 0u, 0u, 0u}; pk[j] = (u32x4){0u, 0u, 0u, 0u};
            if (r < C) { pq[j] = *(const u32x4*)(RQB + (size_t)(row0 + r) * 256 + h * 64 + c8 * 8); pk[j] = *(const u32x4*)(RKB + (size_t)(row0 + r) * 256 + h * 64 + c8 * 8); } }
#pragma unroll
        for (int j = 0; j < 4; ++j) { const int pc = gt + 256 * j, r = pc >> 4, c16 = pc & 15; pv[j] = (u32x4){0u, 0u, 0u, 0u};
            if (r < C) pv[j] = *(const u32x4*)(RVB + (size_t)(row0 + r) * 512 + h * 128 + c16 * 8); } };
    gload(0);
    for (int ci = 0; ci < nch; ++ci) {
        int row0, C; bool state_only; geom(ci, row0, C, state_only);
        asm volatile("s_waitcnt lgkmcnt(0)\n\ts_barrier" ::: "memory");
#pragma unroll
        for (int j = 0; j < 2; ++j) { const int pc = gt + 256 * j, r = pc >> 3, c8 = pc & 7;
            u32x4 kv = pk[j];
            { const float sc = exp2f(-(float)(r + 1) * lg2);
                kv.x = cvtpk(bflo(kv.x) * sc, bfhi(kv.x) * sc); kv.y = cvtpk(bflo(kv.y) * sc, bfhi(kv.y) * sc); kv.z = cvtpk(bflo(kv.z) * sc, bfhi(kv.z) * sc); kv.w = cvtpk(bflo(kv.w) * sc, bfhi(kv.w) * sc); }
            *(LAS u32x4*)(Lq + r * QRS + c8 * 16) = pq[j]; *(LAS u32x4*)(Lk + r * QRS + c8 * 16) = kv; }
#pragma unroll
        for (int j = 0; j < 4; ++j) { const int pc = gt + 256 * j, r = pc >> 4, c16 = pc & 15; *(LAS u32x4*)(Lv + r * VRS + c16 * 16) = pv[j]; }
        if (ci + 1 < nch) gload(ci + 1);
        asm volatile("s_waitcnt lgkmcnt(0)\n\ts_barrier" ::: "memory");
        if (!state_only) {
            u32x2 gpre[2][4];
#pragma unroll
            for (int nsub = 0; nsub < 2; ++nsub)
#pragma unroll
                for (int g4 = 0; g4 < 4; ++g4) gpre[nsub][g4] = *(const u32x2*)(RGB + ((size_t)row0 + nsub * 32 + qr) * 512 + h * 128 + vs + 8 * g4 + 4 * hh);
            bf16x8 pf[2][4];
#pragma unroll
            for (int nsub = 0; nsub < 2; ++nsub)
#pragma unroll
                for (int msub = 0; msub <= nsub; ++msub) {
                    f32x16 st;
#pragma unroll
                    for (int i = 0; i < 16; ++i) st[i] = 0.f;
#pragma unroll
                    for (int s = 0; s < 4; ++s) { const bf16x8 kf = *(const LAS bf16x8*)(Lk + (msub * 32 + qr) * QRS + (16 * s + 8 * hh) * 2); const bf16x8 qv = *(const LAS bf16x8*)(Lq + (nsub * 32 + qr) * QRS + (16 * s + 8 * hh) * 2);
                        st = MFMA32(kf, qv, st); }
                    if (msub == nsub) {
#pragma unroll
                        for (int i = 0; i < 16; ++i) if ((i & 3) + 8 * (i >> 2) > qmh) st[i] = 0.f;
                    }
                    pf[nsub][msub * 2] = pack8(st, 0); pf[nsub][msub * 2 + 1] = pack8(st, 1);
                }
            f32x16 oT[2];
#pragma unroll
            for (int nsub = 0; nsub < 2; ++nsub) {
#pragma unroll
                for (int i = 0; i < 16; ++i) oT[nsub][i] = 0.f;
#pragma unroll
                for (int ks = 0; ks < 2 * nsub + 2; ++ks) {
                    const LAS char* vb = Lv + (ks * 16 + 4 * hh + q4) * VRS + (vs + blk * 16) * 2 + p4 * 8;
                    const bf16x8 vf = cat4(vtr(vb), vtr(vb + 8 * VRS));
                    oT[nsub] = MFMA32(vf, pf[nsub][ks], oT[nsub]);
                }
#pragma unroll
                for (int ksub = 0; ksub < 2; ++ksub)
#pragma unroll
                    for (int s = 0; s < 2; ++s) {
                        const bf16x8 sa = pack8(S[ksub], s);
                        const LAS char* qp = Lq + (nsub * 32 + qr) * QRS + (32 * ksub + 16 * s + 4 * hh) * 2;
                        const s16x4 lo = *(const LAS s16x4*)qp, hi = *(const LAS s16x4*)(qp + 16);
                        oT[nsub] = MFMA32(sa, cat4(lo, hi), oT[nsub]);
                    }
                const float sc = exp2f((float)(nsub * 32 + qr + 1) * lg2);
                float ss = 0.f;
#pragma unroll
                for (int i = 0; i < 16; ++i) { oT[nsub][i] *= sc; ss += oT[nsub][i] * oT[nsub][i]; }
                ss += shx(ss, 32);
                if (hh == 0) red[wq * 64 + nsub * 32 + qr] = ss;
            }
            asm volatile("s_waitcnt lgkmcnt(0)\n\ts_barrier" ::: "memory");
#pragma unroll
            for (int nsub = 0; nsub < 2; ++nsub) {
                const int n = nsub * 32 + qr;
                const float tot = red[n] + red[64 + n] + red[128 + n] + red[192 + n];
                const float r = rsqrtf(tot * (1.0f / 128.f) + EPS);
                const size_t row = (size_t)row0 + n;
#pragma unroll
                for (int g4 = 0; g4 < 4; ++g4) { const int vd = vs + 8 * g4 + 4 * hh;
                    const u32x2 gg = gpre[nsub][g4];
                    u32x2 w; w.x = cvtpk(silu_f(bflo(gg.x)) * oT[nsub][4 * g4] * r, silu_f(bfhi(gg.x)) * oT[nsub][4 * g4 + 1] * r);
                    w.y = cvtpk(silu_f(bflo(gg.y)) * oT[nsub][4 * g4 + 2] * r, silu_f(bfhi(gg.y)) * oT[nsub][4 * g4 + 3] * r);
                    *(u32x2*)(MIX + row * DM + 512 + h * 128 + vd) = w; }
            }
        }
#pragma unroll
        for (int ksub = 0; ksub < 2; ++ksub)
#pragma unroll
            for (int ms = 0; ms < 4; ++ms) {
                if (ms * 16 < C) {
                    const LAS char* ka = Lk + (ms * 16 + 8 * hh + q4) * QRS + (ksub * 32 + blk * 16) * 2 + p4 * 8;
                    const LAS char* va = Lv + (ms * 16 + 8 * hh + q4) * VRS + (vs + blk * 16) * 2 + p4 * 8;
                    S[ksub] = MFMA32(cat4(vtr(ka), vtr(ka + 4 * QRS)), cat4(vtr(va), vtr(va + 4 * VRS)), S[ksub]);
                }
            }
        const float gC = exp2f((float)C * lg2);
#pragma unroll
        for (int ks = 0; ks < 2; ++ks)
#pragma unroll
            for (int i = 0; i < 16; ++i) S[ks][i] *= gC;
    }
    if (mode == 0) {
#pragma unroll
        for (int ks = 0; ks < 2; ++ks)
#pragma unroll
            for (int i = 0; i < 16; ++i) Tb[(size_t)seg * 8192 + (size_t)(32 * ks + crow(i, hh)) * 128] = S[ks][i];
        asm volatile("s_waitcnt vmcnt(0)" ::: "memory");
        __syncthreads();
        if (tid == 0) { __builtin_amdgcn_fence(__ATOMIC_RELEASE, "agent"); asm volatile("s_waitcnt vmcnt(0)" ::: "memory"); __hip_atomic_store(flags + seg, 1u, __ATOMIC_RELAXED, __HIP_MEMORY_SCOPE_AGENT); }
    } else if (mode == 2 || seg == 7) {
        float* sout = p.out + (mode == 2 ? O_SS : O_SP) + ((size_t)(b * 4 + h) * 64) * 128 + vs + qr;
#pragma unroll
        for (int ks = 0; ks < 2; ++ks)
#pragma unroll
            for (int i = 0; i < 16; ++i) sout[(size_t)(32 * ks + crow(i, hh)) * 128] = S[ks][i];
    }
}

constexpr int NU_R1 = 224, NU_AS = 64, NU_A1 = 256, NU_R2 = 256, NU_A2 = 1792, NU_RS = 32, NU_TOTAL = NU_R1 + NU_AS + NU_A1 + NU_R2 + NU_A2 + NU_RS;
DI void p2_units(const Params& p, LAS unsigned char* lds, int dup) {
    const int tid = launder_tid(), lane = tid & 63;
    float lam;
    { float a = p.lam_q1[lane] * p.lam_k1[lane], c = p.lam_q2[lane] * p.lam_k2[lane]; a = wave_sum(a); c = wave_sum(c); lam = __expf(a) - __expf(c) + 0.2f; }
    unsigned* ctr = (unsigned*)(p.ws + WS_CTL) + 128 * dup;
    LAS int* qslot = (LAS int*)(lds + LDS_BYTES - 64);
    for (;;) {
        __syncthreads();
        if (tid == 0) *qslot = (int)atomicAdd(ctr, 1u);
        __syncthreads();
        int u = *qslot;
        if (u >= NU_TOTAL) break;
        if (u < NU_R1) { const int bhp = u / 7, seg = u - bhp * 7; ret_unit(p, lds, 0, bhp >> 1, bhp & 1, seg); continue; }
        u -= NU_R1;
        int kind = 0, bh, uu = 0;
        if (u < NU_AS) { kind = 1; bh = u; }
        else if (u < NU_AS + NU_A1) { const int a = u - NU_AS; bh = a & 63; uu = 31 - (a >> 6); }
        else if (u < NU_AS + NU_A1 + NU_R2) { const int rr = u - NU_AS - NU_A1; ret_unit(p, lds, 1, (rr & 31) >> 1, rr & 1, rr >> 5); continue; }
        else if (u < NU_AS + NU_A1 + NU_R2 + NU_A2) { const int a = u - NU_AS - NU_R2; bh = a & 63; uu = 31 - (a >> 6); }
        else { const int rr = u - NU_AS - NU_A1 - NU_R2 - NU_A2; ret_unit(p, lds, 2, rr >> 1, rr & 1, 0); continue; }
        attn_unit(p, lds, kind, bh >> 2, bh & 3, uu, lam);
    }
}

DI int launder_v(int x) { asm volatile("" : "+v"(x)); return x; }
template <int PH> DI void run_phase(const Params& p, LAS unsigned char* lds, int dup = 0) {
    unsigned char* ws = p.ws;
    const int G = gridDim.x, c = blockIdx.x;
    if (PH == 0) p0_prep(p, lds);
    else if (PH == 1) {
        StaticOrder S; S.init(M1, PIN, G, c);
        Gemm g{(const bf16_t*)(ws + WS_XN), (const bf16_t*)(ws + WS_WIN), M1, PIN, DM};
        EpiIn E{p.g_q, p.g_k, ws, p.out};
        pg8::gemm_phase<EpiIn, StaticOrder, true, true>(lds, g, S, E);
    } else if (PH == 2) p2_units(p, lds, dup);
    else if (PH == 3) {
        StaticOrder S; S.init(M2, DM, G, c);
        Gemm g{(const bf16_t*)(ws + WS_MIX), (const bf16_t*)(ws + WS_WOUT), M2, DM, DM};
        EpiOut E{(const float*)(ws + WS_RINV), (bf16_t*)(ws + WS_XN), (float*)(ws + WS_SSQ)};
        pg8::gemm_phase<EpiOut, StaticOrder, true, true>(lds, g, S, E);
    } else if (PH == 4) {
        StaticOrder S; S.init(M2, NGU, G, c);
        Gemm g{(const bf16_t*)(ws + WS_XN), (const bf16_t*)(ws + WS_WGU), M2, NGU, DM};
        EpiGU E{(const float*)(ws + WS_SSQ), (bf16_t*)(ws + WS_ACT)};
        pg8::gemm_phase<EpiGU, StaticOrder, true, true>(lds, g, S, E);
    } else {
        StaticOrder S; S.init(M2, DM, G, c);
        Gemm g{(const bf16_t*)(ws + WS_ACT), (const bf16_t*)(ws + WS_WDN), M2, DM, DFF};
        EpiDown E{p.out, (const bf16_t*)(ws + WS_XN), lds + 131072};
        pg8::gemm_phase<EpiDown, StaticOrder, true, true>(lds, g, S, E);
    }
}
DI void grid_bar(unsigned* ctr, unsigned target) {
    asm volatile("s_waitcnt vmcnt(0)" ::: "memory");
    __syncthreads();
    if (threadIdx.x == 0) {
        __builtin_amdgcn_fence(__ATOMIC_RELEASE, "agent");
        asm volatile("s_waitcnt vmcnt(0)" ::: "memory");
        (void)__hip_atomic_fetch_add(ctr, 1u, __ATOMIC_RELAXED, __HIP_MEMORY_SCOPE_AGENT);
        while (__hip_atomic_load(ctr, __ATOMIC_RELAXED, __HIP_MEMORY_SCOPE_AGENT) < target) __builtin_amdgcn_s_sleep(1);
        __builtin_amdgcn_fence(__ATOMIC_ACQUIRE, "agent");
        asm volatile("s_waitcnt vmcnt(0)" ::: "memory");
    }
    __syncthreads();
}
#ifndef DUP_PH
#define DUP_PH -1
#endif
#define SEAM(k) do { if (p.ph_hi > 100) cg::this_grid().sync(); grid_bar((unsigned*)(p.ws + WS_CTL) + 64, (++nbar) * gridDim.x); } while (0)
template <int LO, int HI> __global__ void __launch_bounds__(512) hymba_fwd(Params p) {
    extern __shared__ __attribute__((aligned(16))) unsigned char smem[];
    LAS unsigned char* lds = (LAS unsigned char*)smem;
    unsigned nbar = 0;
    if (DUP_PH == 0) { run_phase<0>(p, lds, 1); SEAM(0); }
    if (LO <= 0 && 0 < HI) { run_phase<0>(p, lds); if (1 < HI) SEAM(0 - LO); }
    if (DUP_PH == 1) { run_phase<1>(p, lds, 1); SEAM(0); }
    if (LO <= 1 && 1 < HI) { run_phase<1>(p, lds); if (2 < HI) SEAM(1 - LO); }
    if (DUP_PH == 2) { run_phase<2>(p, lds, 1); SEAM(0); }
    if (LO <= 2 && 2 < HI) { run_phase<2>(p, lds); if (3 < HI) SEAM(2 - LO); }
    if (DUP_PH == 3) { run_phase<3>(p, lds, 1); SEAM(0); }
    if (LO <= 3 && 3 < HI) { run_phase<3>(p, lds); if (4 < HI) SEAM(3 - LO); }
    if (DUP_PH == 4) { run_phase<4>(p, lds, 1); SEAM(0); }
    if (LO <= 4 && 4 < HI) { run_phase<4>(p, lds); if (5 < HI) SEAM(4 - LO); }
    if (LO <= 5 && 5 < HI) { run_phase<5>(p, lds); }
}

template <int LO, int HI> static void launch_range(const Params& p, int grid, hipStream_t stream, bool coop) {
    static bool attr_done = false;
    if (!attr_done) { (void)hipFuncSetAttribute((const void*)hymba_fwd<LO, HI>, hipFuncAttributeMaxDynamicSharedMemorySize, LDS_BYTES); attr_done = true; }
    Params pp = p; void* args[] = {&pp};
    hipError_t e;
    if (coop) e = hipLaunchCooperativeKernel((const void*)hymba_fwd<LO, HI>, dim3(grid), dim3(512), args, LDS_BYTES, stream);
    else e = hipLaunchKernel((const void*)hymba_fwd<LO, HI>, dim3(grid), dim3(512), args, LDS_BYTES, stream);
    if (e != hipSuccess) fprintf(stderr, "launch [%d,%d) failed: %s (grid %d)\n", LO, HI, hipGetErrorString(e), grid);
}
extern "C" void kernel_launch(void* const* d_in, const int* in_sizes, int n_in, void* d_out, int out_size, void* d_ws, size_t ws_size, hipStream_t stream) {
    (void)in_sizes; (void)n_in; (void)out_size;
    static int grid_blocks = 0;
    if (!grid_blocks) {
        int dev = 0, cus = 0, per_cu = 0;
        (void)hipGetDevice(&dev);
        (void)hipDeviceGetAttribute(&cus, hipDeviceAttributeMultiprocessorCount, dev);
#if MK_LAUNCHES == 1
        (void)hipFuncSetAttribute((const void*)hymba_fwd<0, 6>, hipFuncAttributeMaxDynamicSharedMemorySize, LDS_BYTES);
        (void)hipOccupancyMaxActiveBlocksPerMultiprocessor(&per_cu, hymba_fwd<0, 6>, 512, LDS_BYTES);
#else
        per_cu = 1;
#endif
        if (per_cu < 1) per_cu = 1;
        grid_blocks = cus;
        if (ws_size < WS_END) fprintf(stderr, "workspace too small: %zu < %zu\n", ws_size, (size_t)WS_END);
    }
    Params p{};
    const float** f = (const float**)&p;
    for (int i = 0; i < 20; ++i) f[i] = (const float*)d_in[i];
    p.out = (float*)d_out; p.ws = (unsigned char*)d_ws; p.ph_lo = 0; p.ph_hi = 6;
    (void)hipMemsetAsync(d_ws, 0, 8192, stream);
#if MK_LAUNCHES == 1
    launch_range<0, 6>(p, grid_blocks, stream, true);
#else
    launch_range<0, 1>(p, grid_blocks, stream, false); launch_range<1, 2>(p, grid_blocks, stream, false); launch_range<2, 3>(p, grid_blocks, stream, false);
    launch_range<3, 4>(p, grid_blocks, stream, false); launch_range<4, 5>(p, grid_blocks, stream, false); launch_range<5, 6>(p, grid_blocks, stream, false);
#endif
}
```

```cpp
#include <hip/hip_runtime.h>
#include <hip/hip_cooperative_groups.h>
#include <cstdio>
#include <cstdint>
namespace cg = cooperative_groups;
#ifndef PHMASK
#define PHMASK 63
#endif
#ifndef MK_LAUNCHES
#define MK_LAUNCHES 1
#endif
__device__ __forceinline__ int launder_tid() { int x = threadIdx.x; asm volatile("" : "+v"(x)); return x; }
namespace pg8 {
#define PG8_LAS __attribute__((address_space(3)))
typedef unsigned short bf16_t;
typedef short bf16x8 __attribute__((ext_vector_type(8)));
typedef float f32x4 __attribute__((ext_vector_type(4)));
typedef unsigned u32x4 __attribute__((ext_vector_type(4)));
constexpr int BM = 256, BK = 64, HALF = 128, HTB = HALF * BK * 2  , STAGE_BYTES = 8 * HTB, NXCD = 8, WGM = 8;

__host__ __device__ __forceinline__ int lds_byte(int r, int c) { const int st = (r >> 4) * 2 + (c >> 5), rr = r & 15, cc = c & 31, ob = rr * 64 + cc * 2; return st * 1024 + (ob ^ (((ob >> 9) & 1) << 5)); }
__host__ __device__ __forceinline__ void stage_rc(int b, int& R, int& C) { const int st = b / 1024, sb = b % 1024, swz = sb ^ (((sb >> 9) & 1) << 5); R = (st >> 1) * 16 + swz / 64; C = (st & 1) * 32 + (swz % 64) / 2; }
__host__ __device__ __forceinline__ int perm32(int rho) { const int n = rho >> 4, i = rho & 15; return 8 * (i >> 2) + 4 * n + (i & 3); }

struct Unit { int pm, pn; };
struct Gemm { const bf16_t* A; const bf16_t* Bt; int M, N, K; };

struct StaticOrder {
    int nM, nN, nwg, G, c;
    __host__ __device__ void init(int M, int N, int G_, int c_) { nM = M / BM; nN = N / BM; nwg = nM * nN; G = G_; c = c_; }
    __host__ __device__ bool next(int i, Unit& u) const {
        const long L = (long)i * G + c; if (L >= nwg) return false;
        int wgid = (int)L; { const int q = nwg / NXCD, r = nwg % NXCD, xcd = wgid % NXCD, off = wgid / NXCD; wgid = (xcd < r ? xcd * (q + 1) : r * (q + 1) + (xcd - r) * q) + off; }
        const int nig = WGM * nN, gid = wgid / nig, fm = gid * WGM, gsz = (nM - fm) < WGM ? (nM - fm) : WGM;
        u.pm = fm + ((wgid % nig) % gsz); u.pn = (wgid % nig) / gsz; return true;
    }
    __device__ __forceinline__ void a_ready(const Unit&) const {}
    __device__ __forceinline__ void done(const Unit&) const {}
};
template <class Epi, class Sched, bool ALIGN_EPI = false, bool SP2 = false>
__device__ __forceinline__ void gemm_phase(PG8_LAS unsigned char* lds, const Gemm g, const Sched& S, const Epi& E) {
    const int tid = launder_tid(), wid = __builtin_amdgcn_readfirstlane(tid >> 6), lane = tid & 63, wr = wid >> 2, wc = wid & 3, fr = lane & 15, fq = lane >> 4;
    const int K = g.K, nt = K / BK;
    unsigned voffA[2], voffB[2];
#pragma unroll
    for (int i = 0; i < 2; ++i) { int R, C; stage_rc(tid * 16 + i * 8192, R, C); const int Rb = Epi::PERM ? ((R & ~31) + perm32(R & 31)) : R;
        voffA[i] = (unsigned)(R * K + C) * 2u; voffB[i] = (unsigned)(Rb * K + C) * 2u; }
    const size_t kstep = (size_t)(BK * 2);
    const size_t hstep = (size_t)HALF * K * 2;
    const size_t tstep = 2 * hstep;
    const unsigned ldsw = (unsigned)wid * 1024u;
    const int aoff = lds_byte(wr * 64 + fr, fq * 8), boff = lds_byte(wc * 32 + fr, fq * 8);
#define PG8_SA(b, h) (((b) * 2 + (h)) * HTB)
#define PG8_SB(b, h) ((4 + (b) * 2 + (h)) * HTB)
#define PG8_STAGE(bufoff, gbase, voff) do { _Pragma("unroll") for (int _i = 0; _i < 2; ++_i) \
        __builtin_amdgcn_global_load_lds((const unsigned*)((const char*)(gbase) + (voff)[_i]), (PG8_LAS unsigned*)(lds + (bufoff) + ldsw + _i * 8192), 16, 0, 0); } while (0)
#define PG8_LDA(dst, b, h) do { _Pragma("unroll") for (int m = 0; m < 4; ++m) _Pragma("unroll") for (int k = 0; k < 2; ++k) dst[m][k] = *(const PG8_LAS bf16x8*)(lds + PG8_SA(b, h) + aoff + m * 2048 + k * 1024); } while (0)
#define PG8_LDB(dst, b, h) do { _Pragma("unroll") for (int n = 0; n < 2; ++n) _Pragma("unroll") for (int k = 0; k < 2; ++k) dst[n][k] = *(const PG8_LAS bf16x8*)(lds + PG8_SB(b, h) + boff + n * 2048 + k * 1024); } while (0)
#define PG8_MMA(ai, bj, At, Bt) do { __builtin_amdgcn_s_setprio(1); _Pragma("unroll") for (int m = 0; m < 4; ++m) _Pragma("unroll") for (int n = 0; n < 2; ++n) _Pragma("unroll") for (int k = 0; k < 2; ++k) \
        acc[ai][bj][m][n] = __builtin_amdgcn_mfma_f32_16x16x32_bf16(Bt[n][k], At[m][k], acc[ai][bj][m][n], 0, 0, 0); __builtin_amdgcn_s_setprio(0); } while (0)
#define PG8_WAIT_V(n) asm volatile("s_waitcnt vmcnt(" #n ")" ::: "memory")
#define PG8_WAIT_L(n) asm volatile("s_waitcnt lgkmcnt(" #n ")" ::: "memory")
#define PG8_BAR __builtin_amdgcn_s_barrier()
#define PG8_SCHED __builtin_amdgcn_sched_barrier(0)
    Unit cur, nxt; int ui = 0;
    if (!S.next(0, cur)) return;
    f32x4 acc[2][2][4][2];
#pragma unroll
    for (int a = 0; a < 2; ++a)
#pragma unroll
        for (int b = 0; b < 2; ++b)
#pragma unroll
            for (int m = 0; m < 4; ++m)
#pragma unroll
                for (int n = 0; n < 2; ++n) acc[a][b][m][n] = (f32x4){0.f, 0.f, 0.f, 0.f};
    bf16x8 At[4][2], B0[2][2], B1[2][2];
    const char* cA = (const char*)g.A + (size_t)cur.pm * tstep; const char* cB = (const char*)g.Bt + (size_t)cur.pn * tstep;
    S.a_ready(cur);
    if constexpr (SP2) {
        PG8_STAGE(PG8_SB(0, 0), cB, voffB); PG8_STAGE(PG8_SB(0, 1), cB + hstep, voffB); PG8_STAGE(PG8_SA(0, 0), cA, voffA); PG8_STAGE(PG8_SA(0, 1), cA + hstep, voffA);
        if (wr == 1) PG8_BAR;
        PG8_WAIT_V(2); PG8_BAR;
        PG8_STAGE(PG8_SB(1, 0), cB + kstep, voffB); PG8_STAGE(PG8_SA(1, 0), cA + kstep, voffA); PG8_STAGE(PG8_SB(1, 1), cB + hstep + kstep, voffB);
        PG8_WAIT_V(6); PG8_BAR;
    } else {
        PG8_STAGE(PG8_SB(0, 0), cB, voffB); PG8_STAGE(PG8_SA(0, 0), cA, voffA); PG8_STAGE(PG8_SB(0, 1), cB + hstep, voffB); PG8_STAGE(PG8_SA(0, 1), cA + hstep, voffA);
        if (wr == 1) PG8_BAR;
        PG8_WAIT_V(4); PG8_BAR;
        PG8_STAGE(PG8_SB(1, 0), cB + kstep, voffB); PG8_STAGE(PG8_SA(1, 0), cA + kstep, voffA); PG8_STAGE(PG8_SB(1, 1), cB + hstep + kstep, voffB);
        PG8_WAIT_V(6); PG8_BAR;
    }
    for (;;) {
        const bool has_next = S.next(ui + 1, nxt);
        const char* nA = has_next ? (const char*)g.A + (size_t)nxt.pm * tstep : cA; const char* nB = has_next ? (const char*)g.Bt + (size_t)nxt.pn * tstep : cB;
        for (int t = 0; t < nt; t += 2) {
            const bool last = (t == nt - 2);
            const char* a1 = cA + (size_t)(t + 1) * kstep;
            const char* a2 = last ? nA : cA + (size_t)(t + 2) * kstep; const char* b2 = last ? nB : cB + (size_t)(t + 2) * kstep;
            const char* a3 = a2 + kstep; const char* b3 = b2 + kstep;
            if (last && has_next) S.a_ready(nxt);
            if constexpr (SP2) {
            PG8_LDB(B0, 0, 0); PG8_LDB(B1, 0, 1); PG8_SCHED; PG8_LDA(At, 0, 0); PG8_STAGE(PG8_SA(1, 1), a1 + hstep, voffA);
            PG8_WAIT_V(8); PG8_WAIT_L(0); PG8_BAR; PG8_MMA(0, 0, At, B0); PG8_MMA(0, 1, At, B1); PG8_BAR; PG8_SCHED;
            PG8_LDA(At, 0, 1); PG8_STAGE(PG8_SB(0, 0), b2, voffB); PG8_STAGE(PG8_SB(0, 1), b2 + hstep, voffB); PG8_STAGE(PG8_SA(0, 0), a2, voffA);
            PG8_WAIT_V(8); PG8_WAIT_L(0); PG8_BAR; PG8_MMA(1, 0, At, B0); PG8_MMA(1, 1, At, B1); PG8_BAR; PG8_SCHED;
            PG8_LDB(B0, 1, 0); PG8_LDB(B1, 1, 1); PG8_SCHED; PG8_LDA(At, 1, 0); PG8_STAGE(PG8_SA(0, 1), a2 + hstep, voffA);
            PG8_WAIT_V(8); PG8_WAIT_L(0); PG8_BAR; PG8_MMA(0, 0, At, B0); PG8_MMA(0, 1, At, B1); PG8_BAR; PG8_SCHED;
            PG8_LDA(At, 1, 1); PG8_STAGE(PG8_SB(1, 0), b3, voffB); PG8_STAGE(PG8_SB(1, 1), b3 + hstep, voffB); PG8_STAGE(PG8_SA(1, 0), a3, voffA);
            PG8_WAIT_V(8); PG8_WAIT_L(0); PG8_BAR; PG8_MMA(1, 0, At, B0); PG8_MMA(1, 1, At, B1); PG8_BAR; PG8_SCHED;
            } else {
            PG8_LDB(B0, 0, 0); PG8_SCHED; PG8_LDA(At, 0, 0); PG8_STAGE(PG8_SA(1, 1), a1 + hstep, voffA);
            PG8_WAIT_L(8); PG8_BAR; PG8_WAIT_L(0); PG8_MMA(0, 0, At, B0); PG8_BAR; PG8_SCHED;
            PG8_LDB(B1, 0, 1); PG8_STAGE(PG8_SB(0, 0), b2, voffB);
            PG8_BAR; PG8_WAIT_L(0); PG8_MMA(0, 1, At, B1); PG8_BAR;
            PG8_LDA(At, 0, 1); PG8_STAGE(PG8_SA(0, 0), a2, voffA);
            PG8_BAR; PG8_WAIT_L(0); PG8_MMA(1, 0, At, B0); PG8_BAR; PG8_SCHED;
            PG8_STAGE(PG8_SB(0, 1), b2 + hstep, voffB);
            PG8_WAIT_V(6); PG8_BAR; PG8_MMA(1, 1, At, B1); PG8_BAR;
            PG8_LDB(B0, 1, 0); PG8_SCHED; PG8_LDA(At, 1, 0); PG8_STAGE(PG8_SA(0, 1), a2 + hstep, voffA);
            PG8_WAIT_L(8); PG8_BAR; PG8_WAIT_L(0); PG8_MMA(0, 0, At, B0); PG8_BAR; PG8_SCHED;
            PG8_LDB(B1, 1, 1); PG8_STAGE(PG8_SB(1, 0), b3, voffB);
            PG8_BAR; PG8_WAIT_L(0); PG8_MMA(0, 1, At, B1); PG8_BAR;
            PG8_LDA(At, 1, 1); PG8_STAGE(PG8_SA(1, 0), a3, voffA);
            PG8_BAR; PG8_WAIT_L(0); PG8_MMA(1, 0, At, B0); PG8_BAR; PG8_SCHED;
            PG8_STAGE(PG8_SB(1, 1), b3 + hstep, voffB);
            PG8_WAIT_V(6); PG8_BAR; PG8_MMA(1, 1, At, B1); PG8_BAR;
            }
        }
        if constexpr (ALIGN_EPI) { if (wr == 0) PG8_BAR; }
        if constexpr (!Epi::AFTER_DRAIN) { E(acc, cur, wr, wc, fr, fq); S.done(cur); }
        if (!has_next) break;
#pragma unroll
        for (int a = 0; a < 2; ++a)
#pragma unroll
            for (int b = 0; b < 2; ++b)
#pragma unroll
                for (int m = 0; m < 4; ++m)
#pragma unroll
                    for (int n = 0; n < 2; ++n) acc[a][b][m][n] = (f32x4){0.f, 0.f, 0.f, 0.f};
        cur = nxt; cA = nA; cB = nB; ++ui;
        if constexpr (ALIGN_EPI) { if (wr == 1) PG8_BAR; }
    }
    PG8_WAIT_V(0);
    if constexpr (!ALIGN_EPI) { if (wr == 0) PG8_BAR; }
    PG8_BAR;
    if constexpr (Epi::AFTER_DRAIN) { E.fused(acc, cur, wr, wc, fr, fq, lds, wid, lane); S.done(cur); }
#undef PG8_SA
#undef PG8_SB
#undef PG8_STAGE
#undef PG8_LDA
#undef PG8_LDB
#undef PG8_MMA
#undef PG8_WAIT_V
#undef PG8_WAIT_L
#undef PG8_BAR
#undef PG8_SCHED
}
}

typedef unsigned short bf16_t;
typedef short bf16x8 __attribute__((ext_vector_type(8)));
typedef short s16x4 __attribute__((ext_vector_type(4)));
typedef short v4i16_t __attribute__((ext_vector_type(4)));
typedef float f32x4 __attribute__((ext_vector_type(4)));
typedef float f32x16 __attribute__((ext_vector_type(16)));
typedef unsigned u32x4 __attribute__((ext_vector_type(4)));
typedef unsigned u32x2 __attribute__((ext_vector_type(2)));
typedef float f32x2_t __attribute__((ext_vector_type(2)));
typedef __bf16 bf16x2_t __attribute__((ext_vector_type(2)));
#define LAS __attribute__((address_space(3)))
#define DI __device__ __forceinline__
using pg8::Unit; using pg8::Gemm; using pg8::StaticOrder;

constexpr int DM = 1024, SEQ = 4096, NB = 16, NMETA = 16, LCACHE = 4112, DSEQ = 64;
constexpr int ROW_S = 65536, ROW_M = 66560, M1 = 66816, M2 = 66560;
constexpr int PIN = 3072, DFF = 2816, NGU = 5632;
constexpr float EPS = 1e-6f;
constexpr int NPOS = 4176;
constexpr int LDS_BYTES = 163840;
constexpr int LDS_POFF = LDS_BYTES - 64 - 512 * 32;
constexpr size_t O_YP = 0, O_YS = 67108864, O_KP = 68157440, O_VP = 101842944, O_SP = 135528448, O_KS = 136052736, O_VS = 136577024, O_SS = 137101312;
constexpr size_t al256(size_t x) { return (x + 255) & ~(size_t)255; }
constexpr size_t WS_CTL = 0;
constexpr size_t WS_TABA = 8192;
constexpr size_t WS_TABR = al256(WS_TABA + (size_t)NPOS * 16 * 4);
constexpr size_t WS_WIN = al256(WS_TABR + (size_t)NPOS * 64 * 4);
constexpr size_t WS_WOUT = WS_WIN + (size_t)PIN * DM * 2;
constexpr size_t WS_WGU = WS_WOUT + (size_t)DM * DM * 2;
constexpr size_t WS_WDN = WS_WGU + (size_t)NGU * DM * 2;
constexpr size_t WS_XN = WS_WDN + (size_t)DM * DFF * 2;
constexpr size_t WS_SSQ = WS_XN + (size_t)M1 * DM * 2;
constexpr size_t WS_QB = al256(WS_SSQ + (size_t)M2 * 16 * 4);
constexpr size_t WS_KB = WS_QB + (size_t)M1 * 512 * 2;
constexpr size_t WS_VB = WS_KB + (size_t)M1 * 512 * 2;
constexpr size_t WS_RQB = WS_VB + (size_t)M1 * 512 * 2;
constexpr size_t WS_RKB = WS_RQB + (size_t)M1 * 256 * 2;
constexpr size_t WS_RVB = WS_RKB + (size_t)M1 * 256 * 2;
constexpr size_t WS_RGB = WS_RVB + (size_t)M1 * 512 * 2;
constexpr size_t WS_ACT = WS_QB;
constexpr size_t WS_CKB = WS_RGB + (size_t)M1 * 512 * 2;
constexpr size_t WS_CVB = WS_CKB + (size_t)NB * LCACHE * 512 * 2;
constexpr size_t WS_MIX = WS_CVB + (size_t)NB * LCACHE * 512 * 2;
constexpr size_t WS_TLK = WS_MIX + (size_t)M2 * DM * 2;
constexpr size_t WS_TLV = WS_TLK + (size_t)NB * 64 * 512 * 2;
constexpr size_t WS_T = WS_TLV + (size_t)NB * 64 * 512 * 2;
constexpr size_t WS_RINV = WS_T + (size_t)NB * 4 * 8 * 8192 * 4;
constexpr size_t WS_END = WS_RINV + (size_t)M2 * 4;
static_assert(WS_ACT + (size_t)M2 * DFF * 2 <= WS_CKB, "ACT overlay fits");

struct Params {
    const float *x_prompt, *x_sample, *cache_k, *cache_v, *state_ret, *meta, *g_mix, *w_in, *g_q, *g_k, *lam_q1, *lam_k1, *lam_q2, *lam_k2, *g_sub, *w_out, *g_ffn, *w_gate, *w_up, *w_down;
    float* out; unsigned char* ws;
    int ph_lo, ph_hi;
};

DI unsigned cvtpk(float lo, float hi) { f32x2_t v = {lo, hi}; bf16x2_t b = __builtin_convertvector(v, bf16x2_t); return __builtin_bit_cast(unsigned, b); }
DI float bf2f(unsigned short u) { return __uint_as_float(((unsigned)u) << 16); }
DI float bflo(unsigned u) { return __uint_as_float(u << 16); }
DI float bfhi(unsigned u) { return __uint_as_float(u & 0xffff0000u); }
DI int crow(int r, int hi) { return (r & 3) + 8 * (r >> 2) + 4 * hi; }
DI float shx(float v, int m) { return __shfl_xor(v, m, 64); }
DI bf16x8 pack8(const f32x16& x, int s) {
    u32x4 p; p.x = cvtpk(x[8 * s], x[8 * s + 1]); p.y = cvtpk(x[8 * s + 2], x[8 * s + 3]); p.z = cvtpk(x[8 * s + 4], x[8 * s + 5]); p.w = cvtpk(x[8 * s + 6], x[8 * s + 7]);
    return __builtin_bit_cast(bf16x8, p);
}
DI s16x4 vtr(const LAS char* p) { return __builtin_bit_cast(s16x4, __builtin_amdgcn_ds_read_tr16_b64_v4i16((LAS v4i16_t*)p)); }
DI bf16x8 cat4(s16x4 lo, s16x4 hi) { return __builtin_shufflevector(lo, hi, 0, 1, 2, 3, 4, 5, 6, 7); }
#define MFMA32(a, b, c) __builtin_amdgcn_mfma_f32_32x32x16_bf16((a), (b), (c), 0, 0, 0)
DI float silu_f(float x) { return x * __builtin_amdgcn_rcpf(1.0f + __expf(-x)); }
DI float wave_sum(float v) { v += shx(v, 32); v += shx(v, 16); v += shx(v, 8); v += shx(v, 4); v += shx(v, 2); v += shx(v, 1); return v; }

DI int win_src(int n) { const int pn = n >> 8, c = n & 255; if (pn <= 3 || pn == 6 || pn == 7) { const int bj = c >> 7, j = (c >> 5) & 3, e = bj * 32 + (c & 31); return pn * 256 + j * 64 + e; } return n; }

DI void p0_transpose_tile(const float* W0, const float* W1, int ldw, int K, const float* gk, bf16_t* Bt, int mode, int k0, int n0, LAS float* scr) {
    const int tid = launder_tid();
#pragma unroll
    for (int i = 0; i < 8; ++i) { const int idx = tid + 512 * i, kk = idx >> 6, nn = idx & 63, n = n0 + nn;
        const float* W = W0; int src = n;
        if (mode == 1) src = win_src(n);
        else if (mode == 2) { const int pn = n >> 8, c = n & 255; if (c >= 128) W = W1; src = pn * 128 + (c & 127); }
        float v = W[(size_t)(k0 + kk) * ldw + src]; if (gk) v *= gk[k0 + kk];
        scr[kk * 65 + nn] = v; }
    __syncthreads();
    { const int nn = tid >> 3, kg = (tid & 7) * 8;
        u32x4 o; o.x = cvtpk(scr[(kg + 0) * 65 + nn], scr[(kg + 1) * 65 + nn]); o.y = cvtpk(scr[(kg + 2) * 65 + nn], scr[(kg + 3) * 65 + nn]);
        o.z = cvtpk(scr[(kg + 4) * 65 + nn], scr[(kg + 5) * 65 + nn]); o.w = cvtpk(scr[(kg + 6) * 65 + nn], scr[(kg + 7) * 65 + nn]);
        *(u32x4*)(Bt + (size_t)(n0 + nn) * K + k0 + kg) = o; }
    __syncthreads();
}

DI void p0_prep(const Params& p, LAS unsigned char* lds) {
    const int tid = launder_tid(), lane = tid & 63, wid = tid >> 6, G = gridDim.x, bid = blockIdx.x;
    unsigned char* ws = p.ws;
    LAS float* scr = (LAS float*)lds;
    constexpr int T_IN = 16 * 48, T_OUT = 16 * 16, T_GU = 16 * 88, T_DN = 44 * 16;
    for (int it = bid; it < T_IN + T_OUT + T_GU + T_DN; it += G) {
        if (it < T_IN) { const int kt = it / 48, nt = it % 48; p0_transpose_tile(p.w_in, nullptr, PIN, DM, p.g_mix, (bf16_t*)(ws + WS_WIN), 1, kt * 64, nt * 64, scr); }
        else if (it < T_IN + T_OUT) { const int j = it - T_IN, kt = j / 16, nt = j % 16; p0_transpose_tile(p.w_out, nullptr, DM, DM, nullptr, (bf16_t*)(ws + WS_WOUT), 0, kt * 64, nt * 64, scr); }
        else if (it < T_IN + T_OUT + T_GU) { const int j = it - T_IN - T_OUT, kt = j / 88, nt = j % 88; p0_transpose_tile(p.w_gate, p.w_up, DFF, DM, p.g_ffn, (bf16_t*)(ws + WS_WGU), 2, kt * 64, nt * 64, scr); }
        else { const int j = it - T_IN - T_OUT - T_GU, kt = j / 16, nt = j % 16; p0_transpose_tile(p.w_down, nullptr, DM, DFF, nullptr, (bf16_t*)(ws + WS_WDN), 0, kt * 64, nt * 64, scr); }
    }
    bf16_t* XN = (bf16_t*)(ws + WS_XN);
    for (int row0 = (bid * 8 + wid) * 4; row0 < ROW_M + NMETA; row0 += G * 32) {
        f32x4 v[4][4];
#pragma unroll
        for (int j = 0; j < 4; ++j) { const int row = row0 + j < ROW_M + NMETA ? row0 + j : ROW_M + NMETA - 1;
            const float* xr = row < ROW_S ? p.x_prompt + (size_t)row * DM : row < ROW_M ? p.x_sample + (size_t)(row - ROW_S) * DM : p.meta + (size_t)(row - ROW_M) * DM;
            v[j][0] = __builtin_nontemporal_load((const f32x4*)(xr + lane * 8)); v[j][1] = __builtin_nontemporal_load((const f32x4*)(xr + lane * 8 + 4));
            v[j][2] = __builtin_nontemporal_load((const f32x4*)(xr + 512 + lane * 8)); v[j][3] = __builtin_nontemporal_load((const f32x4*)(xr + 512 + lane * 8 + 4)); }
#pragma unroll
        for (int j = 0; j < 4; ++j) { const int row = row0 + j; if (row >= ROW_M + NMETA) break;
            float ss = 0.f;
#pragma unroll
            for (int q = 0; q < 4; ++q)
#pragma unroll
                for (int i = 0; i < 4; ++i) ss += v[j][q][i] * v[j][q][i];
            ss = wave_sum(ss);
            const float r = rsqrtf(ss * (1.0f / DM) + EPS);
            if (lane == 0 && row < ROW_M) ((float*)(ws + WS_RINV))[row] = sqrtf(ss * (1.0f / DM) + EPS);
            u32x4 o0, o1;
            o0.x = cvtpk(v[j][0][0] * r, v[j][0][1] * r); o0.y = cvtpk(v[j][0][2] * r, v[j][0][3] * r); o0.z = cvtpk(v[j][1][0] * r, v[j][1][1] * r); o0.w = cvtpk(v[j][1][2] * r, v[j][1][3] * r);
            o1.x = cvtpk(v[j][2][0] * r, v[j][2][1] * r); o1.y = cvtpk(v[j][2][2] * r, v[j][2][3] * r); o1.z = cvtpk(v[j][3][0] * r, v[j][3][1] * r); o1.w = cvtpk(v[j][3][2] * r, v[j][3][3] * r);
            *(u32x4*)(XN + (size_t)row * DM + lane * 8) = o0; *(u32x4*)(XN + (size_t)row * DM + 512 + lane * 8) = o1; }
    }
    for (int i = bid * 512 + tid; i < 2 * 48 * 64; i += G * 512) { const int which = i / (48 * 64), j = i % (48 * 64);
        *(u32x4*)((bf16_t*)(ws + (which ? WS_VB : WS_KB)) + (size_t)(ROW_M + NMETA) * 512 + (size_t)j * 8) = (u32x4){0u, 0u, 0u, 0u}; }
}

struct EpiIn {
    static constexpr bool PERM = true, AFTER_DRAIN = false;
    const float *gq, *gk; unsigned char* ws; float* out;
    DI void operator()(const f32x4 (&acc)[2][2][4][2], const Unit& u, int wr, int wc, int fr, int fq) const {
        const int pn = u.pn, pm = u.pm;
        const int kind = pm < 256 ? 0 : pm < 260 ? 1 : 2;
        if (pn < 4) {
            const bool isk = pn >= 2; const float* g = isk ? gk : gq;
            const int head = 2 * (pn & 1) + (wc >> 1), cmp = wc & 1;
            f32x4 gv[2][2];
#pragma unroll
            for (int bj = 0; bj < 2; ++bj)
#pragma unroll
                for (int n = 0; n < 2; ++n) gv[bj][n] = *(const f32x4*)(g + 32 * bj + 8 * fq + 4 * n);
            const float sgn = fq == 0 ? -1.f : 1.f; const float qs = isk ? 1.f : 0.18033688011112042f;
            float invr[2][4];
#pragma unroll
            for (int n = 0; n < 2; ++n)
#pragma unroll
                for (int t4 = 0; t4 < 4; ++t4) invr[n][t4] = exp2f(-(float)(4 * n + t4) * (18.931568569324174f / 8.0f)) * 0.15915494309189535f;
#pragma unroll
            for (int ai = 0; ai < 2; ++ai)
#pragma unroll
                for (int m = 0; m < 4; ++m) {
                    const int row = pm * 256 + 128 * ai + 64 * wr + 16 * m + fr;
                    int b, t, pos; bool valid = true;
                    if (kind == 0) { b = row >> 12; t = row & 4095; pos = NMETA + t; } else if (kind == 1) { const int rs = row - ROW_S; b = rs >> 6; t = rs & 63; pos = LCACHE + t; } else { b = 0; t = row - ROW_M; pos = t; valid = t < NMETA; if (!valid) pos = 0; }
                    f32x4 v[2][2]; float ss = 0.f;
#pragma unroll
                    for (int bj = 0; bj < 2; ++bj)
#pragma unroll
                        for (int n = 0; n < 2; ++n) { v[bj][n] = acc[ai][bj][m][n]; ss += v[bj][n][0] * v[bj][n][0] + v[bj][n][1] * v[bj][n][1] + v[bj][n][2] * v[bj][n][2] + v[bj][n][3] * v[bj][n][3]; }
                    ss += shx(ss, 16); ss += shx(ss, 32);
                    const float r = rsqrtf(ss * (1.0f / 64.f) + EPS);
#pragma unroll
                    for (int bj = 0; bj < 2; ++bj)
#pragma unroll
                        for (int n = 0; n < 2; ++n) v[bj][n] = v[bj][n] * r * gv[bj][n];
                    f32x4 pr[2];
#pragma unroll
                    for (int n = 0; n < 2; ++n)
#pragma unroll
                        for (int t4 = 0; t4 < 4; ++t4) pr[n][t4] = shx(v[0][n][t4], 16);
                    if (fq < 2) {
                        const float pf_ = (float)pos;
#pragma unroll
                        for (int n = 0; n < 2; ++n)
#pragma unroll
                            for (int t4 = 0; t4 < 4; ++t4) { const float rev = __builtin_amdgcn_fractf(pf_ * invr[n][t4]);
                                const float cs = __builtin_amdgcn_cosf(rev), sn = __builtin_amdgcn_sinf(rev);
                                v[0][n][t4] = v[0][n][t4] * cs + sgn * pr[n][t4] * sn; }
                    }
                    if (!valid) continue;
                    const int cb = head * 128 + cmp * 64 + 8 * fq;
#pragma unroll
                    for (int bj = 0; bj < 2; ++bj) {
                        u32x4 w; w.x = cvtpk(v[bj][0][0] * qs, v[bj][0][1] * qs); w.y = cvtpk(v[bj][0][2] * qs, v[bj][0][3] * qs); w.z = cvtpk(v[bj][1][0] * qs, v[bj][1][1] * qs); w.w = cvtpk(v[bj][1][2] * qs, v[bj][1][3] * qs);
                        __builtin_nontemporal_store(w, (u32x4*)((bf16_t*)(ws + (isk ? WS_KB : WS_QB)) + (size_t)row * 512 + cb + 32 * bj));
                    }
                    if (isk) {
                        if (kind == 0) { float* o = out + O_KP + ((size_t)(b * LCACHE + NMETA + t)) * 512 + cb;
#pragma unroll
                            for (int bj = 0; bj < 2; ++bj) { __builtin_nontemporal_store(v[bj][0], (f32x4*)(o + 32 * bj)); __builtin_nontemporal_store(v[bj][1], (f32x4*)(o + 32 * bj + 4)); } }
                        else if (kind == 1) { float* o = out + O_KS + ((size_t)(b * DSEQ + t)) * 512 + cb;
#pragma unroll
                            for (int bj = 0; bj < 2; ++bj) { __builtin_nontemporal_store(v[bj][0], (f32x4*)(o + 32 * bj)); __builtin_nontemporal_store(v[bj][1], (f32x4*)(o + 32 * bj + 4)); } }
                        else { for (int b2 = 0; b2 < NB; ++b2) { float* o = out + O_KP + ((size_t)(b2 * LCACHE + t)) * 512 + cb;
#pragma unroll
                                for (int bj = 0; bj < 2; ++bj) { __builtin_nontemporal_store(v[bj][0], (f32x4*)(o + 32 * bj)); __builtin_nontemporal_store(v[bj][1], (f32x4*)(o + 32 * bj + 4)); } } }
                    }
                }
        } else if (pn == 6 || pn == 7) {
            const bool isk = pn == 7; const float sc = isk ? 0.125f : 1.f; const int head = wc;
            float invr[2][4];
#pragma unroll
            for (int n = 0; n < 2; ++n)
#pragma unroll
                for (int t4 = 0; t4 < 4; ++t4) invr[n][t4] = exp2f(-(float)(8 * fq + 4 * n + t4) * (13.287712379549449f / 32.0f)) * 0.15915494309189535f;
#pragma unroll
            for (int ai = 0; ai < 2; ++ai)
#pragma unroll
                for (int m = 0; m < 4; ++m) {
                    const int row = pm * 256 + 128 * ai + 64 * wr + 16 * m + fr;
                    int pos; bool valid = true;
                    if (kind == 0) pos = NMETA + (row & 4095); else if (kind == 1) pos = LCACHE + ((row - ROW_S) & 63); else { pos = row - ROW_M; valid = pos < NMETA; if (!valid) pos = 0; }
                    f32x4 o1[2], o2[2];
                    const float pf_ = (float)pos;
#pragma unroll
                    for (int n = 0; n < 2; ++n) { const f32x4 x1 = acc[ai][0][m][n], x2 = acc[ai][1][m][n];
#pragma unroll
                        for (int t4 = 0; t4 < 4; ++t4) { const float rev = __builtin_amdgcn_fractf(pf_ * invr[n][t4]);
                            const float cs = __builtin_amdgcn_cosf(rev), sn = __builtin_amdgcn_sinf(rev);
                            o1[n][t4] = (x1[t4] * cs - x2[t4] * sn) * sc; o2[n][t4] = (x2[t4] * cs + x1[t4] * sn) * sc; } }
                    if (!valid) continue;
                    bf16_t* d = (bf16_t*)(ws + (isk ? WS_RKB : WS_RQB)) + (size_t)row * 256 + head * 64 + 8 * fq;
                    u32x4 w; w.x = cvtpk(o1[0][0], o1[0][1]); w.y = cvtpk(o1[0][2], o1[0][3]); w.z = cvtpk(o1[1][0], o1[1][1]); w.w = cvtpk(o1[1][2], o1[1][3]); *(u32x4*)d = w;
                    w.x = cvtpk(o2[0][0], o2[0][1]); w.y = cvtpk(o2[0][2], o2[0][3]); w.z = cvtpk(o2[1][0], o2[1][1]); w.w = cvtpk(o2[1][2], o2[1][3]); *(u32x4*)(d + 32) = w;
                }
        } else {
            bf16_t* base; int colt; bool isv = false;
            if (pn < 6) { base = (bf16_t*)(ws + WS_VB); colt = (pn - 4) * 256; isv = true; } else if (pn < 10) { base = (bf16_t*)(ws + WS_RVB); colt = (pn - 8) * 256; } else { base = (bf16_t*)(ws + WS_RGB); colt = (pn - 10) * 256; }
#pragma unroll
            for (int ai = 0; ai < 2; ++ai)
#pragma unroll
                for (int m = 0; m < 4; ++m) {
                    const int row = pm * 256 + 128 * ai + 64 * wr + 16 * m + fr;
                    int b, t; bool valid = true;
                    if (kind == 0) { b = row >> 12; t = row & 4095; } else if (kind == 1) { const int rs = row - ROW_S; b = rs >> 6; t = rs & 63; } else { b = 0; t = row - ROW_M; valid = t < NMETA; }
                    if (!valid) continue;
#pragma unroll
                    for (int bj = 0; bj < 2; ++bj) {
                        const int col = colt + 128 * bj + 32 * wc + 8 * fq;
                        const f32x4 v0 = acc[ai][bj][m][0], v1 = acc[ai][bj][m][1];
                        u32x4 w; w.x = cvtpk(v0[0], v0[1]); w.y = cvtpk(v0[2], v0[3]); w.z = cvtpk(v1[0], v1[1]); w.w = cvtpk(v1[2], v1[3]);
                        __builtin_nontemporal_store(w, (u32x4*)(base + (size_t)row * 512 + col));
                        if (isv) {
                            if (kind == 0) { float* o = out + O_VP + ((size_t)(b * LCACHE + NMETA + t)) * 512 + col; __builtin_nontemporal_store(v0, (f32x4*)o); __builtin_nontemporal_store(v1, (f32x4*)(o + 4)); }
                            else if (kind == 1) { float* o = out + O_VS + ((size_t)(b * DSEQ + t)) * 512 + col; __builtin_nontemporal_store(v0, (f32x4*)o); __builtin_nontemporal_store(v1, (f32x4*)(o + 4)); }
                            else { for (int b2 = 0; b2 < NB; ++b2) { float* o = out + O_VP + ((size_t)(b2 * LCACHE + t)) * 512 + col; __builtin_nontemporal_store(v0, (f32x4*)o); __builtin_nontemporal_store(v1, (f32x4*)(o + 4)); } }
                        }
                    }
                }
        }
    }
};

struct EpiOut {
    static constexpr bool PERM = true, AFTER_DRAIN = false;
    const float* rinv; bf16_t* HB; float* SSQ;
    DI void operator()(const f32x4 (&acc)[2][2][4][2], const Unit& u, int wr, int wc, int fr, int fq) const {
#pragma unroll
        for (int ai = 0; ai < 2; ++ai)
#pragma unroll
            for (int m = 0; m < 4; ++m) {
                const int row = u.pm * 256 + 128 * ai + 64 * wr + 16 * m + fr;
                const float ri = rinv[row];
                float ss = 0.f;
#pragma unroll
                for (int bj = 0; bj < 2; ++bj) {
                    const int col = u.pn * 256 + 128 * bj + 32 * wc + 8 * fq;
                    const u32x4 xb = *(const u32x4*)(HB + (size_t)row * DM + col);
                    f32x4 v0 = acc[ai][bj][m][0], v1 = acc[ai][bj][m][1];
                    v0[0] += bflo(xb.x) * ri; v0[1] += bfhi(xb.x) * ri; v0[2] += bflo(xb.y) * ri; v0[3] += bfhi(xb.y) * ri;
                    v1[0] += bflo(xb.z) * ri; v1[1] += bfhi(xb.z) * ri; v1[2] += bflo(xb.w) * ri; v1[3] += bfhi(xb.w) * ri;
                    u32x4 w; w.x = cvtpk(v0[0], v0[1]); w.y = cvtpk(v0[2], v0[3]); w.z = cvtpk(v1[0], v1[1]); w.w = cvtpk(v1[2], v1[3]);
                    __builtin_nontemporal_store(w, (u32x4*)(HB + (size_t)row * DM + col));
#pragma unroll
                    for (int i = 0; i < 4; ++i) ss += v0[i] * v0[i] + v1[i] * v1[i];
                }
                ss += shx(ss, 16); ss += shx(ss, 32);
                if (fq == 0) SSQ[(size_t)row * 16 + u.pn * 4 + wc] = ss;
            }
    }
};

struct EpiGU {
    static constexpr bool PERM = true, AFTER_DRAIN = false;
    const float* SSQ; bf16_t* ACT;
    DI void operator()(const f32x4 (&acc)[2][2][4][2], const Unit& u, int wr, int wc, int fr, int fq) const {
#pragma unroll
        for (int ai = 0; ai < 2; ++ai)
#pragma unroll
            for (int m = 0; m < 4; ++m) {
                const int row = u.pm * 256 + 128 * ai + 64 * wr + 16 * m + fr;
                const float* sp = SSQ + (size_t)row * 16;
                const f32x4 s0 = *(const f32x4*)sp, s1 = *(const f32x4*)(sp + 4), s2 = *(const f32x4*)(sp + 8), s3 = *(const f32x4*)(sp + 12);
                float ss = 0.f;
#pragma unroll
                for (int i = 0; i < 4; ++i) ss += s0[i] + s1[i] + s2[i] + s3[i];
                const float rs = rsqrtf(ss * (1.0f / DM) + EPS);
                float a[8];
#pragma unroll
                for (int n = 0; n < 2; ++n)
#pragma unroll
                    for (int t = 0; t < 4; ++t) a[4 * n + t] = silu_f(acc[ai][0][m][n][t] * rs) * (acc[ai][1][m][n][t] * rs);
                u32x4 w; w.x = cvtpk(a[0], a[1]); w.y = cvtpk(a[2], a[3]); w.z = cvtpk(a[4], a[5]); w.w = cvtpk(a[6], a[7]);
                __builtin_nontemporal_store(w, (u32x4*)(ACT + (size_t)row * DFF + u.pn * 128 + 32 * wc + 8 * fq));
            }
    }
};

struct EpiDown {
    static constexpr bool PERM = true, AFTER_DRAIN = false;
    float* out; const bf16_t* HB; LAS unsigned char* lstage;
    DI void operator()(const f32x4 (&acc)[2][2][4][2], const Unit& u, int wr, int wc, int fr, int fq) const {
        LAS unsigned char* st = lstage + (wr * 4 + wc) * 4096;
#pragma unroll
        for (int ai = 0; ai < 2; ++ai)
#pragma unroll
            for (int m = 0; m < 4; ++m) {
                const int row0g = u.pm * 256 + 128 * ai + 64 * wr + 16 * m, row = row0g + fr;
#pragma unroll
                for (int bj = 0; bj < 2; ++bj) {
                    const size_t idx = (size_t)row * DM + u.pn * 256 + 128 * bj + 32 * wc + 8 * fq;
                    const u32x4 hb = *(const u32x4*)(HB + idx);
                    f32x4 v0 = acc[ai][bj][m][0], v1 = acc[ai][bj][m][1];
                    v0[0] += bflo(hb.x); v0[1] += bfhi(hb.x); v0[2] += bflo(hb.y); v0[3] += bfhi(hb.y); v1[0] += bflo(hb.z); v1[1] += bfhi(hb.z); v1[2] += bflo(hb.w); v1[3] += bfhi(hb.w);
                    *(LAS f32x4*)(st + fr * 256 + (((bj * 8 + fq * 2) ^ fr) << 4)) = v0; *(LAS f32x4*)(st + fr * 256 + (((bj * 8 + fq * 2 + 1) ^ fr) << 4)) = v1;
                }
                float* ob = out + (size_t)row0g * DM + u.pn * 256 + 128 * (fr >> 3) + 32 * wc + (fr & 7) * 4;
#pragma unroll
                for (int j = 0; j < 4; ++j) { const int rr = 4 * j + fq; const f32x4 d = *(const LAS f32x4*)(st + rr * 256 + ((fr ^ rr) << 4));
                    __builtin_nontemporal_store(d, (f32x4*)(ob + (size_t)rr * DM)); }
            }
    }
};

constexpr int KRS = 272, VRS = 320;
constexpr int SLOT_B = 64 * KRS + 64 * VRS;
constexpr int SLOT_V = 64 * KRS;

DI void stage_tile(LAS char* slot, const bf16_t* Kg, const bf16_t* Vg, int nvalid, int tid) {
#pragma unroll
    for (int j = 0; j < 2; ++j) { const int pc = tid + 512 * j, r = pc >> 4, c16 = pc & 15;
        u32x4 kv = {0u, 0u, 0u, 0u}, vv = {0u, 0u, 0u, 0u};
        if (r < nvalid) { kv = *(const u32x4*)(Kg + (size_t)r * 512 + c16 * 8); vv = *(const u32x4*)(Vg + (size_t)r * 512 + c16 * 8); }
        *(LAS u32x4*)(slot + r * KRS + c16 * 16) = kv; *(LAS u32x4*)(slot + SLOT_V + r * VRS + c16 * 16) = vv; }
}

DI void dma_offsets(unsigned (&poff)[5], int wid, int lane) {
#pragma unroll
    for (int j = 0; j < 5; ++j) { const int g0 = wid * 5 + j, gi = g0 > 36 ? 36 : g0; unsigned off = 0;
        if (gi < 17) { const int sidx = gi * 64 + lane, row = sidx / 17, c = sidx - row * 17; off = (unsigned)(row << 10) | (unsigned)((c > 15 ? 15 : c) << 4); }
        else if (gi < 37) { const int sidx = (gi - 17) * 64 + lane, row = sidx / 20, c = sidx - row * 20; off = (unsigned)(row << 10) | (unsigned)((c > 15 ? 15 : c) << 4); }
        poff[j] = off; }
}
DI void glds16(const void* gbase, unsigned voff, unsigned lds_dst) { unsigned keep;
    asm volatile("s_mov_b32 %0, m0\n\ts_mov_b32 m0, %3\n\ts_nop 0\n\tglobal_load_lds_dwordx4 %1, %2\n\ts_mov_b32 m0, %0" : "=&s"(keep) : "v"(voff), "s"(gbase), "s"(lds_dst) : "memory"); }
DI void dma_tile(LAS char* slot, const bf16_t* Kg, const bf16_t* Vg, const unsigned (&poff)[5], int wid) {
#pragma unroll
    for (int j = 0; j < 5; ++j) { const int g0 = wid * 5 + j, gi = g0 > 36 ? 36 : g0;
        { const bool isk = gi < 17; glds16(isk ? (const void*)Kg : (const void*)Vg, poff[j], (unsigned)(size_t)(isk ? slot + gi * 1024 : slot + SLOT_V + (gi - 17) * 1024)); } }
}

#define SGB(mask, n) __builtin_amdgcn_sched_group_barrier((mask), (n), 0)
DI void attn_qk(const LAS char* kb, const bf16x8 (&qf)[4], bf16x8 (&pf)[4], float& l) {
    f32x16 zero;
#pragma unroll
    for (int i = 0; i < 16; ++i) zero[i] = 0.f;
    bf16x8 k0[4], k1[4];
#pragma unroll
    for (int s = 0; s < 4; ++s) k0[s] = *(const LAS bf16x8*)(kb + 32 * s);
#pragma unroll
    for (int s = 0; s < 4; ++s) k1[s] = *(const LAS bf16x8*)(kb + 32 * KRS + 32 * s);
    f32x16 st0 = MFMA32(k0[0], qf[0], zero), st1 = MFMA32(k1[0], qf[0], zero);
#pragma unroll
    for (int s = 1; s < 4; ++s) { st0 = MFMA32(k0[s], qf[s], st0); st1 = MFMA32(k1[s], qf[s], st1); }
    SGB(0x100, 8); SGB(0x008, 8);
    float sum = 0.f;
#pragma unroll
    for (int i = 0; i < 16; ++i) { const float e = __builtin_amdgcn_exp2f(st0[i]); st0[i] = e; sum += e; }
    pf[0] = pack8(st0, 0); pf[1] = pack8(st0, 1);
#pragma unroll
    for (int i = 0; i < 16; ++i) { const float e = __builtin_amdgcn_exp2f(st1[i]); st1[i] = e; sum += e; }
    pf[2] = pack8(st1, 0); pf[3] = pack8(st1, 1);
    l += sum;
}
DI void attn_pv(const LAS char* vb, const bf16x8 (&pf)[4], f32x16 (&O)[4]) {
    s16x4 va[8], vc[8];
#pragma unroll
    for (int ks = 0; ks < 4; ++ks) { va[2 * ks] = vtr(vb + ks * 16 * VRS); va[2 * ks + 1] = vtr(vb + (ks * 16 + 8) * VRS); }
#pragma unroll
    for (int ks = 0; ks < 4; ++ks) { vc[2 * ks] = vtr(vb + ks * 16 * VRS + 64); vc[2 * ks + 1] = vtr(vb + (ks * 16 + 8) * VRS + 64); }
#pragma unroll
    for (int ks = 0; ks < 4; ++ks) O[0] = MFMA32(cat4(va[2 * ks], va[2 * ks + 1]), pf[ks], O[0]);
#pragma unroll
    for (int ks = 0; ks < 4; ++ks) { va[2 * ks] = vtr(vb + ks * 16 * VRS + 128); va[2 * ks + 1] = vtr(vb + (ks * 16 + 8) * VRS + 128); }
    SGB(0x100, 16); SGB(0x008, 4); SGB(0x100, 8);
#pragma unroll
    for (int ks = 0; ks < 4; ++ks) O[1] = MFMA32(cat4(vc[2 * ks], vc[2 * ks + 1]), pf[ks], O[1]);
#pragma unroll
    for (int ks = 0; ks < 4; ++ks) { vc[2 * ks] = vtr(vb + ks * 16 * VRS + 192); vc[2 * ks + 1] = vtr(vb + (ks * 16 + 8) * VRS + 192); }
    SGB(0x008, 4); SGB(0x100, 8);
#pragma unroll
    for (int ks = 0; ks < 4; ++ks) O[2] = MFMA32(cat4(va[2 * ks], va[2 * ks + 1]), pf[ks], O[2]);
    SGB(0x008, 4);
#pragma unroll
    for (int ks = 0; ks < 4; ++ks) O[3] = MFMA32(cat4(vc[2 * ks], vc[2 * ks + 1]), pf[ks], O[3]);
    SGB(0x008, 4);
}

constexpr int BUF_B = 2 * SLOT_B;
DI void attn_unit(const Params& p, LAS unsigned char* ldsu, int kind, int b, int h, int u, float lam) {
    LAS char* lds = (LAS char*)ldsu;
    const int tid = launder_tid(), lane = tid & 63, wid = __builtin_amdgcn_readfirstlane(tid >> 6), qr = lane & 31, hh = lane >> 5;
    const int cmp = wid >> 2, r = wid & 3;
    unsigned char* ws = p.ws;
    const bf16_t* KB = (const bf16_t*)(ws + WS_KB); const bf16_t* VB = (const bf16_t*)(ws + WS_VB);
    const int hc = h * 128;
    int qrow, my_last, nsteps, ntl;
    if (kind == 0) { qrow = b * SEQ + u * 128 + 32 * r; my_last = 2 * u + (r >> 1) + 1; ntl = 2 * u + 3; nsteps = 0; }
    else { qrow = ROW_S + b * DSEQ + 32 * (r & 1); my_last = r < 2 ? 65 : -1; ntl = 66; nsteps = 0; }
    (void)nsteps;
    bf16x8 qf[4];
    { const bf16_t* qp = (const bf16_t*)(ws + WS_QB) + (size_t)(qrow + qr) * 512 + hc + cmp * 64 + 8 * hh;
#pragma unroll
        for (int s = 0; s < 4; ++s) qf[s] = *(const bf16x8*)(qp + 16 * s); }
    f32x16 O[4]; float l = 0.f;
#pragma unroll
    for (int v = 0; v < 4; ++v)
#pragma unroll
        for (int i = 0; i < 16; ++i) O[v][i] = 0.f;
    const int i16 = lane & 15, q4 = i16 >> 2, p4 = i16 & 3, blk = (lane >> 4) & 1;
    const int kboff = qr * KRS + 16 * hh + cmp * 128, vboff = SLOT_V + (4 * hh + q4) * VRS + blk * 32 + p4 * 8;
#define BAR_LANDED() asm volatile("s_waitcnt vmcnt(10)\n\ts_barrier" ::: "memory")
    if (kind == 0) {
        unsigned poff[5]; dma_offsets(poff, wid, lane);
        auto stage = [&](int t) { if (t >= ntl) t = ntl - 1; const int row0 = t == 0 ? ROW_M : b * SEQ + (t - 1) * 64;
            dma_tile(lds + (t & 3) * SLOT_B, KB + (size_t)row0 * 512 + hc, VB + (size_t)row0 * 512 + hc, poff, wid); };
        stage(0); stage(1); stage(2);
        asm volatile("s_waitcnt vmcnt(10)" ::: "memory");
        __syncthreads();
        for (int t = 0; t < ntl; ++t) {
            stage(t + 3);
            const LAS char* sp = lds + (t & 3) * SLOT_B;
            if (t <= my_last) { bf16x8 pf[4]; attn_qk(sp + kboff, qf, pf, l); attn_pv(sp + vboff, pf, O); }
            BAR_LANDED();
        }
    } else {
        f32x4 kr[4], vr[4];
        auto ld = [&](int t) {
            const float *ks, *vs; int nv = 64;
            if (t == 0) { ks = p.cache_k + ((size_t)b * LCACHE + 4096) * 512 + hc; vs = p.cache_v + ((size_t)b * LCACHE + 4096) * 512 + hc; nv = 16; }
            else if (t < 65) { ks = p.cache_k + ((size_t)b * LCACHE + 64 * (t - 1)) * 512 + hc; vs = p.cache_v + ((size_t)b * LCACHE + 64 * (t - 1)) * 512 + hc; }
            else { ks = p.out + O_KS + (size_t)b * DSEQ * 512 + hc; vs = p.out + O_VS + (size_t)b * DSEQ * 512 + hc; }
#pragma unroll
            for (int j = 0; j < 4; ++j) { const int pc = tid + 512 * j, rr = pc >> 5, c4 = pc & 31;
                kr[j] = (f32x4){0.f, 0.f, 0.f, 0.f}; vr[j] = (f32x4){0.f, 0.f, 0.f, 0.f};
                if (rr < nv) { kr[j] = *(const f32x4*)(ks + (size_t)rr * 512 + c4 * 4); vr[j] = *(const f32x4*)(vs + (size_t)rr * 512 + c4 * 4); } }
        };
        auto st = [&](int t) { LAS char* sp = lds + (t & 1) * SLOT_B;
#pragma unroll
            for (int j = 0; j < 4; ++j) { const int pc = tid + 512 * j, rr = pc >> 5, c4 = pc & 31;
                u32x2 kw, vw; kw.x = cvtpk(kr[j][0], kr[j][1]); kw.y = cvtpk(kr[j][2], kr[j][3]); vw.x = cvtpk(vr[j][0], vr[j][1]); vw.y = cvtpk(vr[j][2], vr[j][3]);
                *(LAS u32x2*)(sp + rr * KRS + c4 * 8) = kw; *(LAS u32x2*)(sp + SLOT_V + rr * VRS + c4 * 8) = vw; } };
        ld(0); st(0); ld(1);
        __syncthreads();
        for (int t = 0; t < ntl; ++t) {
            const LAS char* sp = lds + (t & 1) * SLOT_B;
            if (t <= my_last) { bf16x8 pf[4]; attn_qk(sp + kboff, qf, pf, l); attn_pv(sp + vboff, pf, O); }
            if (t + 1 < ntl) st(t + 1);
            if (t + 2 < ntl) ld(t + 2);
            asm volatile("s_waitcnt lgkmcnt(0)\n\ts_barrier" ::: "memory");
        }
    }
    asm volatile("s_waitcnt vmcnt(0)" ::: "memory");
    __syncthreads();
    const float lt = l + shx(l, 32) - 48.f;
    LAS float* xch = (LAS float*)lds + r * 4096 + lane;
    if (cmp == 1) { const float sc = lam / lt;
#pragma unroll
        for (int v = 0; v < 4; ++v)
#pragma unroll
            for (int i = 0; i < 16; ++i) xch[(v * 16 + i) * 64] = O[v][i] * sc; }
    __syncthreads();
    if (cmp == 0 && my_last >= 0) {
        const float i0 = 1.0f / lt; float ss = 0.f;
#pragma unroll
        for (int v = 0; v < 4; ++v)
#pragma unroll
            for (int i = 0; i < 16; ++i) { const float o = O[v][i] * i0 - xch[(v * 16 + i) * 64]; O[v][i] = o; ss += o * o; }
        ss += shx(ss, 32);
        const float rn = rsqrtf(ss * (1.0f / 128.f) + EPS) * 0.8f;
        LAS char* ost = lds + 65536 + r * (32 * KRS);
#pragma unroll
        for (int v = 0; v < 4; ++v)
#pragma unroll
            for (int g4 = 0; g4 < 4; ++g4) { const int vd = v * 32 + 8 * g4 + 4 * hh; const f32x4 gs = *(const f32x4*)(p.g_sub + vd);
                u32x2 w; w.x = cvtpk(O[v][4 * g4] * rn * gs[0], O[v][4 * g4 + 1] * rn * gs[1]); w.y = cvtpk(O[v][4 * g4 + 2] * rn * gs[2], O[v][4 * g4 + 3] * rn * gs[3]);
                *(LAS u32x2*)(ost + qr * KRS + vd * 2) = w; }
        bf16_t* dst = (bf16_t*)(ws + WS_MIX) + (size_t)qrow * DM + hc;
#pragma unroll
        for (int j = 0; j < 8; ++j) { const int pc = lane + 64 * j, row = pc >> 4, c16 = pc & 15;
            const u32x4 d = *(const LAS u32x4*)(ost + row * KRS + c16 * 16);
            *(u32x4*)(dst + (size_t)row * DM + c16 * 8) = d; }
    }
}

constexpr int QRS = 144;
constexpr int RG_B = 2 * 64 * QRS + 64 * VRS;
DI void ret_unit(const Params& p, LAS unsigned char* ldsu, int mode, int b, int hp, int seg) {
    LAS char* lds = (LAS char*)ldsu;
    const int tid = launder_tid(), lane = tid & 63, wid = __builtin_amdgcn_readfirstlane(tid >> 6), qr = lane & 31, hh = lane >> 5;
    const int g = wid >> 2, wq = wid & 3, h = 2 * hp + g, vs = wq * 32, gt = tid & 255;
    unsigned char* ws = p.ws;
    const bf16_t* RQB = (const bf16_t*)(ws + WS_RQB); const bf16_t* RKB = (const bf16_t*)(ws + WS_RKB); const bf16_t* RVB = (const bf16_t*)(ws + WS_RVB); const bf16_t* RGB = (const bf16_t*)(ws + WS_RGB);
    bf16_t* MIX = (bf16_t*)(ws + WS_MIX);
    LAS char* Lq = lds + g * RG_B; LAS char* Lk = Lq + 64 * QRS; LAS char* Lv = Lk + 64 * QRS;
    LAS float* red = (LAS float*)(lds + 2 * RG_B) + g * 256;
    LAS char* ost = lds + 81920 + wid * 5120;
    const float lg2 = log2f(1.0f - exp2f(-5.0f - (float)h));
    unsigned* flags = (unsigned*)(ws + WS_CTL) + 1024 + (b * 2 + hp) * 8;
    float* Tb = (float*)(ws + WS_T) + ((size_t)(b * 4 + h) * 8) * 8192 + vs + qr;
    f32x16 S[2];
#pragma unroll
    for (int ks = 0; ks < 2; ++ks)
#pragma unroll
        for (int i = 0; i < 16; ++i) S[ks][i] = 0.f;
    if (mode == 2) { const float* sin_ = p.state_ret + ((size_t)(b * 4 + h) * 64) * 128 + vs + qr;
#pragma unroll
        for (int ks = 0; ks < 2; ++ks)
#pragma unroll
            for (int i = 0; i < 16; ++i) S[ks][i] = sin_[(size_t)(32 * ks + crow(i, hh)) * 128]; }
    else if (mode == 1 && seg > 0) {
        if (tid == 0) { for (int sp = 0; sp < seg; ++sp) while (__hip_atomic_load(flags + sp, __ATOMIC_RELAXED, __HIP_MEMORY_SCOPE_AGENT) == 0u) __builtin_amdgcn_s_sleep(2);
            __builtin_amdgcn_fence(__ATOMIC_ACQUIRE, "agent"); asm volatile("s_waitcnt vmcnt(0)" ::: "memory"); }
        __syncthreads();
        for (int sp = 0; sp < seg; ++sp) { const float w = exp2f(512.f * (float)(seg - 1 - sp) * lg2); const float* tp = Tb + (size_t)sp * 8192;
#pragma unroll
            for (int ks = 0; ks < 2; ++ks)
#pragma unroll
                for (int i = 0; i < 16; ++i) S[ks][i] += w * __builtin_nontemporal_load(tp + (size_t)(32 * ks + crow(i, hh)) * 128); }
    }
    const int nch = mode == 2 ? 1 : (seg == 0 ? 9 : 8);
    const int i16 = lane & 15, q4 = i16 >> 2, p4 = i16 & 3, blk = (lane >> 4) & 1, qmh = qr - 4 * hh;
    auto geom = [&](int ci, int& row0, int& C, bool& so) { C = 64; so = mode == 0;
        if (mode == 2) row0 = ROW_S + b * DSEQ;
        else if (seg == 0) { if (ci == 0) { row0 = ROW_M; C = NMETA; so = true; } else row0 = b * SEQ + (ci - 1) * 64; }
        else row0 = b * SEQ + (8 * seg + ci) * 64; };
    u32x4 pq[2], pk[2], pv[4];
    auto gload = [&](int ci) { int row0, C; bool so; geom(ci, row0, C, so);
#pragma unroll
        for (int j = 0; j < 2; ++j) { const int pc = gt + 256 * j, r = pc >> 3, c8 = pc & 7; pq[j] = (u32x4){0u, 0u, 0u, 0u}; pk[j] = (u32x4){0u, 0u, 0u, 0u};
            if (r < C) { pq[j] = *(const u32x4*)(RQB + (size_t)(row0 + r) * 256 + h * 64 + c8 * 8); pk[j] = *(const u32x4*)(RKB + (size_t)(row0 + r) * 256 + h * 64 + c8 * 8); } }
#pragma unroll
        for (int j = 0; j < 4; ++j) { const int pc = gt + 256 * j, r = pc >> 4, c16 = pc & 15; pv[j] = (u32x4){0u, 0u, 0u, 0u};
            if (r < C) pv[j] = *(const u32x4*)(RVB + (size_t)(row0 + r) * 512 + h * 128 + c16 * 8); } };
    gload(0);
    for (int ci = 0; ci < nch; ++ci) {
        int row0, C; bool state_only; geom(ci, row0, C, state_only);
        asm volatile("s_waitcnt lgkmcnt(0)\n\ts_barrier" ::: "memory");
#pragma unroll
        for (int j = 0; j < 2; ++j) { const int pc = gt + 256 * j, r = pc >> 3, c8 = pc & 7;
            u32x4 kv = pk[j];
            { const float sc = exp2f(-(float)(r + 1) * lg2);
                kv.x = cvtpk(bflo(kv.x) * sc, bfhi(kv.x) * sc); kv.y = cvtpk(bflo(kv.y) * sc, bfhi(kv.y) * sc); kv.z = cvtpk(bflo(kv.z) * sc, bfhi(kv.z) * sc); kv.w = cvtpk(bflo(kv.w) * sc, bfhi(kv.w) * sc); }
            *(LAS u32x4*)(Lq + r * QRS + c8 * 16) = pq[j]; *(LAS u32x4*)(Lk + r * QRS + c8 * 16) = kv; }
#pragma unroll
        for (int j = 0; j < 4; ++j) { const int pc = gt + 256 * j, r = pc >> 4, c16 = pc & 15; *(LAS u32x4*)(Lv + r * VRS + c16 * 16) = pv[j]; }
        if (ci + 1 < nch) gload(ci + 1);
        asm volatile("s_waitcnt lgkmcnt(0)\n\ts_barrier" ::: "memory");
        if (!state_only) {
            u32x2 gpre[2][4];
#pragma unroll
            for (int nsub = 0; nsub < 2; ++nsub)
#pragma unroll
                for (int g4 = 0; g4 < 4; ++g4) gpre[nsub][g4] = *(const u32x2*)(RGB + ((size_t)row0 + nsub * 32 + qr) * 512 + h * 128 + vs + 8 * g4 + 4 * hh);
            bf16x8 pf[2][4];
#pragma unroll
            for (int nsub = 0; nsub < 2; ++nsub)
#pragma unroll
                for (int msub = 0; msub <= nsub; ++msub) {
                    f32x16 st;
#pragma unroll
                    for (int i = 0; i < 16; ++i) st[i] = 0.f;
#pragma unroll
                    for (int s = 0; s < 4; ++s) { const bf16x8 kf = *(const LAS bf16x8*)(Lk + (msub * 32 + qr) * QRS + (16 * s + 8 * hh) * 2); const bf16x8 qv = *(const LAS bf16x8*)(Lq + (nsub * 32 + qr) * QRS + (16 * s + 8 * hh) * 2);
                        st = MFMA32(kf, qv, st); }
                    if (msub == nsub) {
#pragma unroll
                        for (int i = 0; i < 16; ++i) if ((i & 3) + 8 * (i >> 2) > qmh) st[i] = 0.f;
                    }
                    pf[nsub][msub * 2] = pack8(st, 0); pf[nsub][msub * 2 + 1] = pack8(st, 1);
                }
            f32x16 oT[2];
#pragma unroll
            for (int nsub = 0; nsub < 2; ++nsub) {
#pragma unroll
                for (int i = 0; i < 16; ++i) oT[nsub][i] = 0.f;
#pragma unroll
                for (int ks = 0; ks < 2 * nsub + 2; ++ks) {
                    const LAS char* vb = Lv + (ks * 16 + 4 * hh + q4) * VRS + (vs + blk * 16) * 2 + p4 * 8;
                    const bf16x8 vf = cat4(vtr(vb), vtr(vb + 8 * VRS));
                    oT[nsub] = MFMA32(vf, pf[nsub][ks], oT[nsub]);
                }
#pragma unroll
                for (int ksub = 0; ksub < 2; ++ksub)
#pragma unroll
                    for (int s = 0; s < 2; ++s) {
                        const bf16x8 sa = pack8(S[ksub], s);
                        const LAS char* qp = Lq + (nsub * 32 + qr) * QRS + (32 * ksub + 16 * s + 4 * hh) * 2;
                        const s16x4 lo = *(const LAS s16x4*)qp, hi = *(const LAS s16x4*)(qp + 16);
                        oT[nsub] = MFMA32(sa, cat4(lo, hi), oT[nsub]);
                    }
                const float sc = exp2f((float)(nsub * 32 + qr + 1) * lg2);
                float ss = 0.f;
#pragma unroll
                for (int i = 0; i < 16; ++i) { oT[nsub][i] *= sc; ss += oT[nsub][i] * oT[nsub][i]; }
                ss += shx(ss, 32);
                if (hh == 0) red[wq * 64 + nsub * 32 + qr] = ss;
            }
            asm volatile("s_waitcnt lgkmcnt(0)\n\ts_barrier" ::: "memory");
#pragma unroll
            for (int nsub = 0; nsub < 2; ++nsub) {
                const int n = nsub * 32 + qr;
                const float tot = red[n] + red[64 + n] + red[128 + n] + red[192 + n];
                const float r = rsqrtf(tot * (1.0f / 128.f) + EPS);
#pragma unroll
                for (int g4 = 0; g4 < 4; ++g4) {
                    const u32x2 gg = gpre[nsub][g4];
                    u32x2 w; w.x = cvtpk(silu_f(bflo(gg.x)) * oT[nsub][4 * g4] * r, silu_f(bfhi(gg.x)) * oT[nsub][4 * g4 + 1] * r);
                    w.y = cvtpk(silu_f(bflo(gg.y)) * oT[nsub][4 * g4 + 2] * r, silu_f(bfhi(gg.y)) * oT[nsub][4 * g4 + 3] * r);
                    *(LAS u32x2*)(ost + n * 80 + (8 * g4 + 4 * hh) * 2) = w; }
            }
#pragma unroll
            for (int j = 0; j < 4; ++j) { const int pc = lane + 64 * j, rw = pc >> 2, c = pc & 3;
                const u32x4 d = *(const LAS u32x4*)(ost + rw * 80 + c * 16);
                *(u32x4*)(MIX + ((size_t)row0 + rw) * DM + 512 + h * 128 + vs + c * 8) = d; }
        }
#pragma unroll
        for (int ksub = 0; ksub < 2; ++ksub)
#pragma unroll
            for (int ms = 0; ms < 4; ++ms) {
                if (ms * 16 < C) {
                    const LAS char* ka = Lk + (ms * 16 + 8 * hh + q4) * QRS + (ksub * 32 + blk * 16) * 2 + p4 * 8;
                    const LAS char* va = Lv + (ms * 16 + 8 * hh + q4) * VRS + (vs + blk * 16) * 2 + p4 * 8;
                    S[ksub] = MFMA32(cat4(vtr(ka), vtr(ka + 4 * QRS)), cat4(vtr(va), vtr(va + 4 * VRS)), S[ksub]);
                }
            }
        const float gC = exp2f((float)C * lg2);
#pragma unroll
        for (int ks = 0; ks < 2; ++ks)
#pragma unroll
            for (int i = 0; i < 16; ++i) S[ks][i] *= gC;
    }
    if (mode == 0) {
#pragma unroll
        for (int ks = 0; ks < 2; ++ks)
#pragma unroll
            for (int i = 0; i < 16; ++i) Tb[(size_t)seg * 8192 + (size_t)(32 * ks + crow(i, hh)) * 128] = S[ks][i];
        asm volatile("s_waitcnt vmcnt(0)" ::: "memory");
        __syncthreads();
        if (tid == 0) { __builtin_amdgcn_fence(__ATOMIC_RELEASE, "agent"); asm volatile("s_waitcnt vmcnt(0)" ::: "memory"); __hip_atomic_store(flags + seg, 1u, __ATOMIC_RELAXED, __HIP_MEMORY_SCOPE_AGENT); }
    } else if (mode == 2 || seg == 7) {
        float* sout = p.out + (mode == 2 ? O_SS : O_SP) + ((size_t)(b * 4 + h) * 64) * 128 + vs + qr;
#pragma unroll
        for (int ks = 0; ks < 2; ++ks)
#pragma unroll
            for (int i = 0; i < 16; ++i) sout[(size_t)(32 * ks + crow(i, hh)) * 128] = S[ks][i];
    }
}

constexpr int NU_R1 = 224, NU_AS = 64, NU_A1 = 256, NU_R2 = 256, NU_A2 = 1792, NU_RS = 32, NU_TOTAL = NU_R1 + NU_AS + NU_A1 + NU_R2 + NU_A2 + NU_RS;
DI void p2_units(const Params& p, LAS unsigned char* lds, int dup) {
    const int tid = launder_tid(), lane = tid & 63;
    float lam;
    { float a = p.lam_q1[lane] * p.lam_k1[lane], c = p.lam_q2[lane] * p.lam_k2[lane]; a = wave_sum(a); c = wave_sum(c); lam = __expf(a) - __expf(c) + 0.2f; }
    unsigned* ctr = (unsigned*)(p.ws + WS_CTL) + 128 * dup;
    LAS int* qslot = (LAS int*)(lds + LDS_BYTES - 64);
    for (;;) {
        __syncthreads();
        if (tid == 0) *qslot = (int)atomicAdd(ctr, 1u);
        __syncthreads();
        int u = *qslot;
        if (u >= NU_TOTAL) break;
        if (u < NU_R1) { const int bhp = u / 7, seg = u - bhp * 7; ret_unit(p, lds, 0, bhp >> 1, bhp & 1, seg); continue; }
        u -= NU_R1;
        int kind = 0, bh, uu = 0;
        if (u < NU_AS) { kind = 1; bh = u; }
        else if (u < NU_AS + NU_A1) { const int a = u - NU_AS; bh = a & 63; uu = 31 - (a >> 6); }
        else if (u < NU_AS + NU_A1 + NU_R2) { const int rr = u - NU_AS - NU_A1; ret_unit(p, lds, 1, (rr & 31) >> 1, rr & 1, rr >> 5); continue; }
        else if (u < NU_AS + NU_A1 + NU_R2 + NU_A2) { const int a = u - NU_AS - NU_R2; bh = a & 63; uu = 31 - (a >> 6); }
        else { const int rr = u - NU_AS - NU_A1 - NU_R2 - NU_A2; ret_unit(p, lds, 2, rr >> 1, rr & 1, 0); continue; }
        attn_unit(p, lds, kind, bh >> 2, bh & 3, uu, lam);
    }
}

DI int launder_v(int x) { asm volatile("" : "+v"(x)); return x; }
template <int PH> DI void run_phase(const Params& p, LAS unsigned char* lds, int dup = 0) {
    unsigned char* ws = p.ws;
    const int G = gridDim.x, c = blockIdx.x;
    if (PH == 0) p0_prep(p, lds);
    else if (PH == 1) {
        StaticOrder S; S.init(M1, PIN, G, c);
        Gemm g{(const bf16_t*)(ws + WS_XN), (const bf16_t*)(ws + WS_WIN), M1, PIN, DM};
        EpiIn E{p.g_q, p.g_k, ws, p.out};
        pg8::gemm_phase<EpiIn, StaticOrder, true, true>(lds, g, S, E);
    } else if (PH == 2) p2_units(p, lds, dup);
    else if (PH == 3) {
        StaticOrder S; S.init(M2, DM, G, c);
        Gemm g{(const bf16_t*)(ws + WS_MIX), (const bf16_t*)(ws + WS_WOUT), M2, DM, DM};
        EpiOut E{(const float*)(ws + WS_RINV), (bf16_t*)(ws + WS_XN), (float*)(ws + WS_SSQ)};
        pg8::gemm_phase<EpiOut, StaticOrder, true, true>(lds, g, S, E);
    } else if (PH == 4) {
        StaticOrder S; S.init(M2, NGU, G, c);
        Gemm g{(const bf16_t*)(ws + WS_XN), (const bf16_t*)(ws + WS_WGU), M2, NGU, DM};
        EpiGU E{(const float*)(ws + WS_SSQ), (bf16_t*)(ws + WS_ACT)};
        pg8::gemm_phase<EpiGU, StaticOrder, true, true>(lds, g, S, E);
    } else {
        StaticOrder S; S.init(M2, DM, G, c);
        Gemm g{(const bf16_t*)(ws + WS_ACT), (const bf16_t*)(ws + WS_WDN), M2, DM, DFF};
        EpiDown E{p.out, (const bf16_t*)(ws + WS_XN), lds + 131072};
        pg8::gemm_phase<EpiDown, StaticOrder, true, true>(lds, g, S, E);
    }
}
DI void grid_bar(unsigned* ctr, unsigned target) {
    asm volatile("s_waitcnt vmcnt(0)" ::: "memory");
    __syncthreads();
    if (threadIdx.x == 0) {
        __builtin_amdgcn_fence(__ATOMIC_RELEASE, "agent");
        asm volatile("s_waitcnt vmcnt(0)" ::: "memory");
        (void)__hip_atomic_fetch_add(ctr, 1u, __ATOMIC_RELAXED, __HIP_MEMORY_SCOPE_AGENT);
        while (__hip_atomic_load(ctr, __ATOMIC_RELAXED, __HIP_MEMORY_SCOPE_AGENT) < target) __builtin_amdgcn_s_sleep(1);
        __builtin_amdgcn_fence(__ATOMIC_ACQUIRE, "agent");
        asm volatile("s_waitcnt vmcnt(0)" ::: "memory");
    }
    __syncthreads();
}
#ifndef DUP_PH
#define DUP_PH -1
#endif
#define SEAM(k) do { if (p.ph_hi > 100) cg::this_grid().sync(); grid_bar((unsigned*)(p.ws + WS_CTL) + 64, (++nbar) * gridDim.x); } while (0)
template <int LO, int HI> __global__ void __launch_bounds__(512) hymba_fwd(Params p) {
    extern __shared__ __attribute__((aligned(16))) unsigned char smem[];
    LAS unsigned char* lds = (LAS unsigned char*)smem;
    unsigned nbar = 0;
    if (DUP_PH == 0) { run_phase<0>(p, lds, 1); SEAM(0); }
    if (LO <= 0 && 0 < HI) { run_phase<0>(p, lds); if (1 < HI) SEAM(0 - LO); }
    if (DUP_PH == 1) { run_phase<1>(p, lds, 1); SEAM(0); }
    if (LO <= 1 && 1 < HI) { run_phase<1>(p, lds); if (2 < HI) SEAM(1 - LO); }
    if (DUP_PH == 2) { run_phase<2>(p, lds, 1); SEAM(0); }
    if (LO <= 2 && 2 < HI) { run_phase<2>(p, lds); if (3 < HI) SEAM(2 - LO); }
    if (DUP_PH == 3) { run_phase<3>(p, lds, 1); SEAM(0); }
    if (LO <= 3 && 3 < HI) { run_phase<3>(p, lds); if (4 < HI) SEAM(3 - LO); }
    if (DUP_PH == 4) { run_phase<4>(p, lds, 1); SEAM(0); }
    if (LO <= 4 && 4 < HI) { run_phase<4>(p, lds); if (5 < HI) SEAM(4 - LO); }
    if (LO <= 5 && 5 < HI) { run_phase<5>(p, lds); }
}

template <int LO, int HI> static void launch_range(const Params& p, int grid, hipStream_t stream, bool coop) {
    static bool attr_done = false;
    if (!attr_done) { (void)hipFuncSetAttribute((const void*)hymba_fwd<LO, HI>, hipFuncAttributeMaxDynamicSharedMemorySize, LDS_BYTES); attr_done = true; }
    Params pp = p; void* args[] = {&pp};
    hipError_t e;
    if (coop) e = hipLaunchCooperativeKernel((const void*)hymba_fwd<LO, HI>, dim3(grid), dim3(512), args, LDS_BYTES, stream);
    else e = hipLaunchKernel((const void*)hymba_fwd<LO, HI>, dim3(grid), dim3(512), args, LDS_BYTES, stream);
    if (e != hipSuccess) fprintf(stderr, "launch [%d,%d) failed: %s (grid %d)\n", LO, HI, hipGetErrorString(e), grid);
}
extern "C" void kernel_launch(void* const* d_in, const int* in_sizes, int n_in, void* d_out, int out_size, void* d_ws, size_t ws_size, hipStream_t stream) {
    (void)in_sizes; (void)n_in; (void)out_size;
    static int grid_blocks = 0;
    if (!grid_blocks) {
        int dev = 0, cus = 0, per_cu = 0;
        (void)hipGetDevice(&dev);
        (void)hipDeviceGetAttribute(&cus, hipDeviceAttributeMultiprocessorCount, dev);
#if MK_LAUNCHES == 1
        (void)hipFuncSetAttribute((const void*)hymba_fwd<0, 6>, hipFuncAttributeMaxDynamicSharedMemorySize, LDS_BYTES);
        (void)hipOccupancyMaxActiveBlocksPerMultiprocessor(&per_cu, hymba_fwd<0, 6>, 512, LDS_BYTES);
#else
        per_cu = 1;
#endif
        if (per_cu < 1) per_cu = 1;
        grid_blocks = cus;
        if (ws_size < WS_END) fprintf(stderr, "workspace too small: %zu < %zu\n", ws_size, (size_t)WS_END);
    }
    Params p{};
    const float** f = (const float**)&p;
    for (int i = 0; i < 20; ++i) f[i] = (const float*)d_in[i];
    p.out = (float*)d_out; p.ws = (unsigned char*)d_ws; p.ph_lo = 0; p.ph_hi = 6;
    (void)hipMemsetAsync(d_ws, 0, 8192, stream);
#if MK_LAUNCHES == 1
    launch_range<0, 6>(p, grid_blocks, stream, true);
#else
    launch_range<0, 1>(p, grid_blocks, stream, false); launch_range<1, 2>(p, grid_blocks, stream, false); launch_range<2, 3>(p, grid_blocks, stream, false);
    launch_range<3, 4>(p, grid_blocks, stream, false); launch_range<4, 5>(p, grid_blocks, stream, false); launch_range<5, 6>(p, grid_blocks, stream, false);
#endif
}
```
